# Optimizing an MI355X kernel written in HIP

```python
import math
import jax
import jax.numpy as jnp
from jax import lax
import numpy as np

D_MODEL = 1024
BATCH = 16
SEQ = 2048
DEPTH = 1

PLE_DIM = 256
MIX_WIDTH = D_MODEL
ATTN_WIDTH = MIX_WIDTH // 2
ATTN_HEAD_DIM = 64
ATTN_HEADS = ATTN_WIDTH // ATTN_HEAD_DIM
ATTN_PATTERNS = ((128, 1), (512, 4), (2048, 16))
ROPE_THETA = 500000.0
ROT_DIM = ATTN_HEAD_DIM // 4
MLSTM_WIDTH = MIX_WIDTH - ATTN_WIDTH
MLSTM_HEADS = 4
MLSTM_HEAD_DIM = MLSTM_WIDTH // MLSTM_HEADS
MLSTM_CHUNK = 64
MLSTM_CONV = 3
FFN_DIM = ((8 * D_MODEL // 3) + 255) // 256 * 256
FFN_CONV = 3
EPS = 1e-6
IN_WIDTHS = (ATTN_WIDTH,) * 3 + (MLSTM_WIDTH,) * 3 + (MLSTM_HEADS,) * 4
IN_DIM = sum(IN_WIDTHS)
IN_SPLITS = tuple(int(s) for s in np.cumsum(IN_WIDTHS)[:-1])

kernel_name = "hybrid_dilated_attn_mlstm_convffn_encoder"


def rmsnorm(x, g):
    xf = x.astype(jnp.float32)
    y = xf * lax.rsqrt(jnp.mean(jnp.square(xf), axis=-1, keepdims=True) + EPS)
    return (y * g.astype(jnp.float32)).astype(x.dtype)


def dwconv_centred(x, w, b):
    K = w.shape[0]
    S = x.shape[1]
    pad = K // 2
    xp = jnp.pad(x, ((0, 0), (pad, pad), (0, 0)))
    out = xp[:, 0:S, :] * w[0]
    for j in range(1, K):
        out = out + xp[:, j:j + S, :] * w[j]
    return out + b


def partial_rotary(t, positions):
    half = ROT_DIM // 2
    inv = jnp.power(ROPE_THETA, -jnp.arange(0, ROT_DIM, 2, dtype=jnp.float32) / ROT_DIM)
    ang = positions.astype(jnp.float32)[..., None] * inv
    cos = jnp.cos(ang)[:, :, None, :]
    sin = jnp.sin(ang)[:, :, None, :]
    t1 = t[..., :half]
    t2 = t[..., half:ROT_DIM]
    return jnp.concatenate([t1 * cos - t2 * sin, t2 * cos + t1 * sin, t[..., ROT_DIM:]], axis=-1)


def banded_attention(q, k, v, radius):
    B, H, R, M, hd = q.shape
    blk = radius
    nb = -(-M // blk)
    Mp = nb * blk
    qb = jnp.pad(q, ((0, 0),) * 3 + ((0, Mp - M), (0, 0))).reshape(B, H, R, nb, blk, hd)

    def windows(t):
        tp = jnp.pad(t, ((0, 0),) * 3 + ((blk, Mp - M + blk), (0, 0))).reshape(B, H, R, nb + 2, blk, hd)
        return jnp.concatenate([tp[:, :, :, j:j + nb] for j in range(3)], axis=-2)

    kw = windows(k)
    vw = windows(v)
    qpos = jnp.arange(Mp).reshape(nb, blk)
    kpos = (jnp.arange(nb)[:, None] - 1) * blk + jnp.arange(3 * blk)[None, :]
    valid = ((jnp.abs(qpos[:, :, None] - kpos[:, None, :]) <= radius)
             & (kpos[:, None, :] >= 0) & (kpos[:, None, :] < M))
    s = jnp.einsum('bhrnqd,bhrnkd->bhrnqk', qb, kw)
    s = jnp.where(valid, s, -jnp.inf)
    lse = jax.nn.logsumexp(s, axis=-1)
    o = jnp.einsum('bhrnqk,bhrnkd->bhrnqd', jnp.exp(s - lse[..., None]), vw)
    return o.reshape(B, H, R, Mp, hd)[:, :, :, :M], lse.reshape(B, H, R, Mp)[:, :, :, :M]


def dilated_branch(q, k, v, dil, n_side):
    B, H, S, hd = q.shape
    M = S // dil

    def to_res(t):
        return t.reshape(B, H, M, dil, hd).transpose(0, 1, 3, 2, 4)

    o, lse = banded_attention(to_res(q), to_res(k), to_res(v), n_side)
    return (o.transpose(0, 1, 3, 2, 4).reshape(B, H, S, hd),
            lse.transpose(0, 1, 3, 2).reshape(B, H, S))


def dilated_mixture_attention(q, k, v, positions):
    B, S, H, hd = q.shape
    q = partial_rotary(q, positions) * (hd ** -0.5)
    k = partial_rotary(k, positions)
    q, k, v = (t.transpose(0, 2, 1, 3) for t in (q, k, v))
    outs, lses = [], []
    for window, dil in ATTN_PATTERNS:
        o, l = dilated_branch(q, k, v, dil, (window // 2) // dil)
        outs.append(o)
        lses.append(l)
    wts = jax.nn.softmax(jnp.stack(lses, axis=0), axis=0)
    out = jnp.sum(wts[..., None] * jnp.stack(outs, axis=0), axis=0)
    return out.transpose(0, 2, 1, 3).reshape(B, S, H * hd)


def mlstm_scan(q, k, v, i_pre, f_pre):
    B, H, S, d = q.shape
    L = MLSTM_CHUNK
    nc = S // L

    def chunks(t):
        return jnp.moveaxis(t.reshape((B, H, nc, L) + t.shape[3:]), 2, 0)

    logf = jax.nn.log_sigmoid(f_pre)
    tril = jnp.tril(jnp.ones((L, L), dtype=bool))

    def step(carry, inp):
        C, n, m = carry
        qc, kc, vc, ic, lf = inp
        b = jnp.cumsum(lf, axis=-1)
        dmat = jnp.where(tril, b[..., :, None] - b[..., None, :] + ic[..., None, :], -jnp.inf)
        m_inter = b + m[..., None]
        m_t = jnp.maximum(m_inter, jnp.max(dmat, axis=-1))
        pmat = jnp.einsum('bhtd,bhsd->bhts', qc, kc) * jnp.exp(dmat - m_t[..., None])
        a = jnp.exp(m_inter - m_t)
        num = a[..., None] * jnp.einsum('bhtd,bhde->bhte', qc, C) + jnp.einsum('bhts,bhse->bhte', pmat, vc)
        den = a * jnp.einsum('bhtd,bhd->bht', qc, n) + jnp.sum(pmat, axis=-1)
        h = num / jnp.maximum(jnp.abs(den), jnp.exp(-m_t))[..., None]
        g = b[..., -1]
        logw = g[..., None] - b + ic
        m_new = jnp.maximum(g + m, jnp.max(logw, axis=-1))
        decay = jnp.exp(g + m - m_new)
        w = jnp.exp(logw - m_new[..., None])
        C = decay[..., None, None] * C + jnp.einsum('bhs,bhsd,bhse->bhde', w, kc, vc)
        n = decay[..., None] * n + jnp.einsum('bhs,bhsd->bhd', w, kc)
        return (C, n, m_new), h

    init = (jnp.zeros((B, H, d, d), jnp.float32), jnp.zeros((B, H, d), jnp.float32),
            jnp.zeros((B, H), jnp.float32))
    _, h = lax.scan(step, init, (chunks(q), chunks(k), chunks(v), chunks(i_pre), chunks(logf)))
    return jnp.moveaxis(h, 0, 2).reshape(B, H, S, d)


def mlstm_mixer(u, v, o, i_f, i_b, f_f, f_b, conv_w, conv_b, w_q, w_k, b_ig, b_fg, gn_g):
    B, S, _ = u.shape
    H, d = MLSTM_HEADS, MLSTM_HEAD_DIM
    uc = jax.nn.silu(dwconv_centred(u, conv_w, conv_b)).reshape(B, S, H, d)
    q = jnp.einsum('bshd,hde->bhse', uc, w_q)
    k = jnp.einsum('bshd,hde->bhse', uc, w_k) * (d ** -0.5)
    vh = v.reshape(B, S, H, d).transpose(0, 2, 1, 3)

    def gate(g, b):
        return (g + b).transpose(0, 2, 1)

    def flip(t):
        return jnp.flip(t, axis=2)

    h_fwd = mlstm_scan(q, k, vh, gate(i_f, b_ig[0]), gate(f_f, b_fg[0]))
    h_bwd = flip(mlstm_scan(flip(q), flip(k), flip(vh), flip(gate(i_b, b_ig[1])), flip(gate(f_b, b_fg[1]))))
    hs = h_fwd + h_bwd
    mu = jnp.mean(hs, axis=-1, keepdims=True)
    var = jnp.mean(jnp.square(hs - mu), axis=-1, keepdims=True)
    hn = ((hs - mu) * lax.rsqrt(var + EPS)).transpose(0, 2, 1, 3).reshape(B, S, H * d)
    return hn * gn_g * jax.nn.sigmoid(o)


def conv_glu_ffn(h, w_gate, conv_w, conv_b, w_up, w_down):
    a = dwconv_centred(h @ w_gate, conv_w, conv_b)
    return (jax.nn.gelu(a, approximate=False) * (h @ w_up)) @ w_down


def setup_inputs(seed: int = 0) -> dict:
    key = jax.random.key(seed)
    ks = jax.random.split(key, 32)

    def nrm(k, shape, scale):
        return jax.random.normal(k, shape, jnp.float32) * scale

    def gain(k, shape):
        return 1.0 + nrm(k, shape, 0.02)

    H = MLSTM_HEADS
    fg_bias = jnp.broadcast_to(jnp.linspace(3.0, 6.0, H, dtype=jnp.float32), (DEPTH, 2, H))
    return {
        'x': nrm(ks[0], (BATCH, SEQ, D_MODEL), 1.0),
        'p': nrm(ks[1], (DEPTH, BATCH, SEQ, PLE_DIM), 1.0),
        'positions': jnp.broadcast_to(jnp.arange(SEQ, dtype=jnp.int32), (BATCH, SEQ)),
        'ln_mix_g': gain(ks[2], (DEPTH, D_MODEL)),
        'w_in': nrm(ks[3], (DEPTH, D_MODEL, IN_DIM), D_MODEL ** -0.5),
        'mlstm_conv_w': nrm(ks[4], (DEPTH, MLSTM_CONV, MLSTM_WIDTH), MLSTM_CONV ** -0.5),
        'mlstm_conv_b': nrm(ks[5], (DEPTH, MLSTM_WIDTH), 0.02),
        'w_mq': nrm(ks[6], (DEPTH, H, MLSTM_HEAD_DIM, MLSTM_HEAD_DIM), MLSTM_HEAD_DIM ** -0.5),
        'w_mk': nrm(ks[7], (DEPTH, H, MLSTM_HEAD_DIM, MLSTM_HEAD_DIM), MLSTM_HEAD_DIM ** -0.5),
        'b_igate': nrm(ks[8], (DEPTH, 2, H), 0.1),
        'b_fgate': fg_bias + nrm(ks[9], (DEPTH, 2, H), 0.1),
        'mlstm_gn_g': gain(ks[10], (DEPTH, MLSTM_WIDTH)),
        'w_out': nrm(ks[11], (DEPTH, MIX_WIDTH, D_MODEL), MIX_WIDTH ** -0.5),
        'ln_ffn_g': gain(ks[12], (DEPTH, D_MODEL)),
        'w_ffn_gate': nrm(ks[13], (DEPTH, D_MODEL, FFN_DIM), D_MODEL ** -0.5),
        'ffn_conv_w': nrm(ks[14], (DEPTH, FFN_CONV, FFN_DIM), FFN_CONV ** -0.5),
        'ffn_conv_b': nrm(ks[15], (DEPTH, FFN_DIM), 0.02),
        'w_ffn_up': nrm(ks[16], (DEPTH, D_MODEL, FFN_DIM), D_MODEL ** -0.5),
        'w_ffn_down': nrm(ks[17], (DEPTH, FFN_DIM, D_MODEL), FFN_DIM ** -0.5),
        'ln_ple_g': gain(ks[18], (DEPTH, D_MODEL)),
        'w_ple_gate': nrm(ks[19], (DEPTH, D_MODEL, D_MODEL), D_MODEL ** -0.5),
        'b_ple_gate': nrm(ks[20], (DEPTH, D_MODEL), 0.02),
        'w_ple_proj': nrm(ks[21], (DEPTH, PLE_DIM, D_MODEL), PLE_DIM ** -0.5),
        'ln_final_g': gain(ks[22], (D_MODEL,)),
    }


def reference(x, p, positions, ln_mix_g, w_in, mlstm_conv_w, mlstm_conv_b, w_mq, w_mk,
              b_igate, b_fgate, mlstm_gn_g, w_out, ln_ffn_g, w_ffn_gate, ffn_conv_w,
              ffn_conv_b, w_ffn_up, w_ffn_down, ln_ple_g, w_ple_gate, b_ple_gate,
              w_ple_proj, ln_final_g):
    B, S, _ = x.shape
    f32 = jnp.float32
    for i in range(DEPTH):
        h = rmsnorm(x, ln_mix_g[i])
        z = (h @ w_in[i]).astype(f32)
        q_a, k_a, v_a, u_m, v_m, o_m, i_f, i_b, f_f, f_b = jnp.split(z, IN_SPLITS, axis=-1)
        attn = dilated_mixture_attention(
            q_a.reshape(B, S, ATTN_HEADS, ATTN_HEAD_DIM),
            k_a.reshape(B, S, ATTN_HEADS, ATTN_HEAD_DIM),
            v_a.reshape(B, S, ATTN_HEADS, ATTN_HEAD_DIM), positions)
        mem = mlstm_mixer(u_m, v_m, o_m, i_f, i_b, f_f, f_b,
                          mlstm_conv_w[i].astype(f32), mlstm_conv_b[i].astype(f32),
                          w_mq[i].astype(f32), w_mk[i].astype(f32),
                          b_igate[i].astype(f32), b_fgate[i].astype(f32),
                          mlstm_gn_g[i].astype(f32))
        mixed = jnp.concatenate([attn, mem], axis=-1).astype(x.dtype)
        x = x + mixed @ w_out[i]
        h = rmsnorm(x, ln_ffn_g[i])
        x = x + conv_glu_ffn(h, w_ffn_gate[i], ffn_conv_w[i], ffn_conv_b[i], w_ffn_up[i], w_ffn_down[i])
        h = rmsnorm(x, ln_ple_g[i])
        x = x + (p[i] @ w_ple_proj[i]) * jax.nn.sigmoid(h @ w_ple_gate[i] + b_ple_gate[i])
    return rmsnorm(x, ln_final_g)
```

```cpp
#ifndef REP_ATTN
#define REP_ATTN 1
#endif
#ifndef REP_G
#define REP_G 1
#endif
#ifndef REP_MISC
#define REP_MISC 1
#endif
#ifndef REP_SYNC
#define REP_SYNC 0
#endif
#ifndef REP_SCAN
#define REP_SCAN 1
#endif
#include <hip/hip_runtime.h>
#include <hip/hip_cooperative_groups.h>
#include <cstdio>
#include <cstdint>
#include <cmath>
namespace cg = cooperative_groups;

#define LAS __attribute__((address_space(3)))
typedef unsigned short bf16_t;
typedef short bf16x8 __attribute__((ext_vector_type(8)));
typedef short bf16x4 __attribute__((ext_vector_type(4)));
typedef float f32x4 __attribute__((ext_vector_type(4)));
typedef float f32x2 __attribute__((ext_vector_type(2)));
typedef unsigned u32x4 __attribute__((ext_vector_type(4)));
typedef unsigned u32x2 __attribute__((ext_vector_type(2)));

constexpr int NB = 16, SEQ = 2048, DM = 1024, MTOK = NB * SEQ;
constexpr int ZW = 3072;
constexpr int NZPAD = 3328;
constexpr int NIN = 3088;
constexpr int FF = 2816;
constexpr int NGU = 2 * FF;
constexpr float EPSF = 1e-6f;

constexpr size_t MiB = 1u << 20;
constexpr size_t WS_R0 = 0, WS_SS1 = 128 * 1024, WS_SS2 = 256 * 1024, WS_SS3 = 384 * 1024;
constexpr size_t WS_BAR = 512 * 1024;
constexpr size_t WS_CS = 1 * MiB, WS_GATES = 3 * MiB;
constexpr size_t WS_WIN = 5 * MiB, WS_WOUT = 12 * MiB, WS_WG = 14 * MiB, WS_WU = 20 * MiB, WS_WD = 26 * MiB, WS_WPG = 32 * MiB, WS_WPP = 34 * MiB;
constexpr size_t WS_PB = 36 * MiB;
constexpr size_t WS_XB = 52 * MiB, WS_HF = 52 * MiB, WS_HB = 84 * MiB;
constexpr size_t WS_ZB = 116 * MiB;
constexpr size_t WS_VT1 = 308 * MiB, WS_VT4 = 340 * MiB, WS_VT16 = 372 * MiB;
constexpr size_t WS_MIX = 404 * MiB;
constexpr size_t WS_GP = 116 * MiB, WS_ACT = 292 * MiB, WS_SG = 116 * MiB;
constexpr size_t WS_HALO = 470 * MiB;
constexpr size_t WS_NEED = 480 * MiB;

constexpr int LDS_BYTES = 147456;
constexpr int LDS_ST_OFF = 147392;

struct Params {
    const float* x; const float* p; const int* pos;
    const float* ln_mix_g; const float* w_in; const float* mconv_w; const float* mconv_b; const float* w_mq; const float* w_mk;
    const float* b_ig; const float* b_fg; const float* gn_g; const float* w_out; const float* ln_ffn_g; const float* w_fg; const float* fconv_w; const float* fconv_b;
    const float* w_fu; const float* w_fd; const float* ln_ple_g; const float* w_pg; const float* b_pg; const float* w_pp; const float* ln_f_g;
    float* out; unsigned char* ws;
    double invrev[8];
};

typedef __bf16 bf16x2v __attribute__((ext_vector_type(2)));
__device__ __forceinline__ unsigned f2bf(float f) { return (unsigned)__builtin_bit_cast(unsigned short, (__bf16)f); }
__device__ __forceinline__ unsigned pk2(float lo, float hi) { f32x2 v = {lo, hi}; bf16x2v b = __builtin_convertvector(v, bf16x2v); return __builtin_bit_cast(unsigned, b); }
__device__ __forceinline__ float bflo(unsigned w) { return __builtin_bit_cast(float, w << 16); }
__device__ __forceinline__ float bfhi(unsigned w) { return __builtin_bit_cast(float, w & 0xffff0000u); }
__device__ __forceinline__ float bf1(bf16_t h) { return __builtin_bit_cast(float, ((unsigned)h) << 16); }
__device__ __forceinline__ float wave_sum(float v) {
#pragma unroll
    for (int o = 1; o < 64; o <<= 1) v += __shfl_xor(v, o);
    return v;
}
__device__ __forceinline__ float sigmoidf_(float x) { return 1.0f / (1.0f + __expf(-x)); }
__device__ __forceinline__ float gelu1(float v) {
    const float av = fabsf(v), d = av * 0.2316418882f + 1.0f;
    const float t = __builtin_amdgcn_rcpf(d);
    float q = t * 0.5307027145f + (-0.7265760135f); q = q * t + 0.7107068705f; q = q * t + (-0.142248368f); q = q * t + 0.127414796f; q = q * t;
    const float e = __builtin_amdgcn_exp2f((v * v) * (-0.72134752044f));
    const float m = v * (q * e), r = v - m;
    return v < 0.f ? m : r;
}

namespace pg8 {
constexpr int BM = 256, BK = 64, HALF = 128, HTB = HALF * BK * 2, STAGE_BYTES = 8 * HTB, NXCD = 8, WGM = 8;
__host__ __device__ __forceinline__ int lds_byte(int r, int c) { const int st = (r >> 4) * 2 + (c >> 5), rr = r & 15, cc = c & 31, ob = rr * 64 + cc * 2; return st * 1024 + (ob ^ (((ob >> 9) & 1) << 5)); }
__host__ __device__ __forceinline__ void stage_rc(int b, int& R, int& C) { const int st = b / 1024, sb = b % 1024, swz = sb ^ (((sb >> 9) & 1) << 5); R = (st >> 1) * 16 + swz / 64; C = (st & 1) * 32 + (swz % 64) / 2; }
__host__ __device__ __forceinline__ int perm32(int rho) { const int n = rho >> 4, i = rho & 15; return 8 * (i >> 2) + 4 * n + (i & 3); }

struct Unit { int pm, pn; };
struct Gemm { const bf16_t* A; const bf16_t* Bt; int M, N, K; };

struct StaticOrder {
    int nM, nN, nwg, G, c;
    __device__ void init(int M, int N, int G_, int c_) { nM = M / BM; nN = N / BM; nwg = nM * nN; G = G_; c = c_; }
    __device__ bool next(int i, Unit& u) const {
        const long L = (long)i * G + c; if (L >= nwg) return false;
        int wgid = (int)L; { const int q = nwg / NXCD, r = nwg % NXCD, xcd = wgid % NXCD, off = wgid / NXCD; wgid = (xcd < r ? xcd * (q + 1) : r * (q + 1) + (xcd - r) * q) + off; }
        const int nig = WGM * nN, gid = wgid / nig, fm = gid * WGM, gsz = (nM - fm) < WGM ? (nM - fm) : WGM;
        u.pm = fm + ((wgid % nig) % gsz); u.pn = (wgid % nig) / gsz; return true;
    }
};

template <class Epi, bool ALIGN_EPI>
__device__ __forceinline__ void gemm_phase(LAS unsigned char* lds, const Gemm g, const StaticOrder& S, const Epi& E) {
    int tid = threadIdx.x; asm volatile("" : "+v"(tid));
    const int wid = __builtin_amdgcn_readfirstlane(tid >> 6), lane = tid & 63, wr = wid >> 2, wc = wid & 3, fr = lane & 15, fq = lane >> 4;
    const int K = g.K, nt = K / BK;
    unsigned voffA[2], voffB[2];
#pragma unroll
    for (int i = 0; i < 2; ++i) { int R, C; stage_rc(tid * 16 + i * 8192, R, C); const int Rb = Epi::PERM ? ((R & ~31) + perm32(R & 31)) : R;
        voffA[i] = (unsigned)(R * K + C) * 2u; voffB[i] = (unsigned)(Rb * K + C) * 2u; }
    const size_t kstep = (size_t)(BK * 2);
    const size_t hstep = (size_t)HALF * K * 2;
    const size_t tstep = 2 * hstep;
    const unsigned ldsw = (unsigned)wid * 1024u;
    const int aoff = lds_byte(wr * 64 + fr, fq * 8), boff = lds_byte(wc * 32 + fr, fq * 8);
#define PG8_SA(b, h) (((b) * 2 + (h)) * HTB)
#define PG8_SB(b, h) ((4 + (b) * 2 + (h)) * HTB)
#define PG8_STAGE(bufoff, gbase, voff) do { _Pragma("unroll") for (int _i = 0; _i < 2; ++_i) \
        __builtin_amdgcn_global_load_lds((const unsigned*)((const char*)(gbase) + (voff)[_i]), (LAS unsigned*)(lds + (bufoff) + ldsw + _i * 8192), 16, 0, 0); } while (0)
#define PG8_LDA(dst, b, h) do { _Pragma("unroll") for (int m = 0; m < 4; ++m) _Pragma("unroll") for (int k = 0; k < 2; ++k) dst[m][k] = *(const LAS bf16x8*)(lds + PG8_SA(b, h) + aoff + m * 2048 + k * 1024); } while (0)
#define PG8_LDB(dst, b, h) do { _Pragma("unroll") for (int n = 0; n < 2; ++n) _Pragma("unroll") for (int k = 0; k < 2; ++k) dst[n][k] = *(const LAS bf16x8*)(lds + PG8_SB(b, h) + boff + n * 2048 + k * 1024); } while (0)
#define PG8_MMA(ai, bj, At, Bt) do { __builtin_amdgcn_s_setprio(1); _Pragma("unroll") for (int m = 0; m < 4; ++m) _Pragma("unroll") for (int n = 0; n < 2; ++n) _Pragma("unroll") for (int k = 0; k < 2; ++k) \
        acc[ai][bj][m][n] = __builtin_amdgcn_mfma_f32_16x16x32_bf16(Bt[n][k], At[m][k], acc[ai][bj][m][n], 0, 0, 0); __builtin_amdgcn_s_setprio(0); } while (0)
#define PG8_WAIT_V(n) asm volatile("s_waitcnt vmcnt(" #n ")" ::: "memory")
#define PG8_WAIT_L(n) asm volatile("s_waitcnt lgkmcnt(" #n ")" ::: "memory")
#define PG8_BAR __builtin_amdgcn_s_barrier()
#define PG8_SCHED __builtin_amdgcn_sched_barrier(0)
    Unit cur, nxt; int ui = 0;
    if (!S.next(0, cur)) return;
    f32x4 acc[2][2][4][2];
#pragma unroll
    for (int a = 0; a < 2; ++a)
#pragma unroll
        for (int b = 0; b < 2; ++b)
#pragma unroll
            for (int m = 0; m < 4; ++m)
#pragma unroll
                for (int n = 0; n < 2; ++n) acc[a][b][m][n] = (f32x4){0.f, 0.f, 0.f, 0.f};
    bf16x8 At[4][2], B0[2][2], B1[2][2];
    const char* cA = (const char*)g.A + (size_t)cur.pm * tstep; const char* cB = (const char*)g.Bt + (size_t)cur.pn * tstep;
    PG8_STAGE(PG8_SB(0, 0), cB, voffB); PG8_STAGE(PG8_SB(0, 1), cB + hstep, voffB); PG8_STAGE(PG8_SA(0, 0), cA, voffA); PG8_STAGE(PG8_SA(0, 1), cA + hstep, voffA);
    if (wr == 1) PG8_BAR;
    PG8_WAIT_V(2); PG8_BAR;
    PG8_STAGE(PG8_SB(1, 0), cB + kstep, voffB); PG8_STAGE(PG8_SA(1, 0), cA + kstep, voffA); PG8_STAGE(PG8_SB(1, 1), cB + hstep + kstep, voffB);
    PG8_WAIT_V(6); PG8_BAR;
    for (;;) {
        const bool has_next = S.next(ui + 1, nxt);
        const char* nA = has_next ? (const char*)g.A + (size_t)nxt.pm * tstep : cA; const char* nB = has_next ? (const char*)g.Bt + (size_t)nxt.pn * tstep : cB;
        for (int t = 0; t < nt; t += 2) {
            const bool last = (t == nt - 2);
            const char* a1 = cA + (size_t)(t + 1) * kstep;
            const char* a2 = last ? nA : cA + (size_t)(t + 2) * kstep; const char* b2 = last ? nB : cB + (size_t)(t + 2) * kstep;
            const char* a3 = a2 + kstep; const char* b3 = b2 + kstep;
            PG8_LDB(B0, 0, 0); PG8_LDB(B1, 0, 1); PG8_SCHED; PG8_LDA(At, 0, 0); PG8_STAGE(PG8_SA(1, 1), a1 + hstep, voffA);
            PG8_WAIT_V(8); PG8_WAIT_L(0); PG8_BAR; PG8_MMA(0, 0, At, B0); PG8_MMA(0, 1, At, B1); PG8_BAR; PG8_SCHED;
            PG8_LDA(At, 0, 1); PG8_STAGE(PG8_SB(0, 0), b2, voffB); PG8_STAGE(PG8_SB(0, 1), b2 + hstep, voffB); PG8_STAGE(PG8_SA(0, 0), a2, voffA);
            PG8_WAIT_V(8); PG8_WAIT_L(0); PG8_BAR; PG8_MMA(1, 0, At, B0); PG8_MMA(1, 1, At, B1); PG8_BAR; PG8_SCHED;
            PG8_LDB(B0, 1, 0); PG8_LDB(B1, 1, 1); PG8_SCHED; PG8_LDA(At, 1, 0); PG8_STAGE(PG8_SA(0, 1), a2 + hstep, voffA);
            PG8_WAIT_V(8); PG8_WAIT_L(0); PG8_BAR; PG8_MMA(0, 0, At, B0); PG8_MMA(0, 1, At, B1); PG8_BAR; PG8_SCHED;
            PG8_LDA(At, 1, 1); PG8_STAGE(PG8_SB(1, 0), b3, voffB); PG8_STAGE(PG8_SB(1, 1), b3 + hstep, voffB); PG8_STAGE(PG8_SA(1, 0), a3, voffA);
            PG8_WAIT_V(8); PG8_WAIT_L(0); PG8_BAR; PG8_MMA(1, 0, At, B0); PG8_MMA(1, 1, At, B1); PG8_BAR; PG8_SCHED;
        }
        if constexpr (ALIGN_EPI) { if (wr == 0) PG8_BAR; }
        E(acc, cur, wr, wc, fr, fq);
        if (!has_next) break;
#pragma unroll
        for (int a = 0; a < 2; ++a)
#pragma unroll
            for (int b = 0; b < 2; ++b)
#pragma unroll
                for (int m = 0; m < 4; ++m)
#pragma unroll
                    for (int n = 0; n < 2; ++n) acc[a][b][m][n] = (f32x4){0.f, 0.f, 0.f, 0.f};
        cur = nxt; cA = nA; cB = nB; ++ui;
        if constexpr (ALIGN_EPI) { if (wr == 1) PG8_BAR; }
    }
    PG8_WAIT_V(0);
    if constexpr (!ALIGN_EPI) { if (wr == 0) PG8_BAR; }
    PG8_BAR;
#undef PG8_SA
#undef PG8_SB
#undef PG8_STAGE
#undef PG8_LDA
#undef PG8_LDB
#undef PG8_MMA
#undef PG8_WAIT_V
#undef PG8_WAIT_L
#undef PG8_BAR
#undef PG8_SCHED
}

typedef f32x4 AccT[2][2][4][2];

struct EpiZ {
    static constexpr bool PERM = true;
    bf16_t* ZB; float* gates; const float* r0; const float* cs; bf16_t* VT16;
    __device__ __forceinline__ void operator()(const AccT& acc, const Unit& u, int wr, int wc, int fr, int fq) const {
        const int row0 = u.pm * BM + wr * 64 + fr; const int pn = u.pn;
        if (pn == 12) {
            if (wc == 0 && fq < 2) {
#pragma unroll
                for (int ai = 0; ai < 2; ++ai)
#pragma unroll
                    for (int m = 0; m < 4; ++m) { const int row = row0 + ai * HALF + m * 16; const float r = r0[row];
                        *(f32x4*)(gates + (size_t)row * 16 + 8 * fq) = acc[ai][0][m][0] * r; *(f32x4*)(gates + (size_t)row * 16 + 8 * fq + 4) = acc[ai][0][m][1] * r; }
            }
            return;
        }
        if (pn == 4 || pn == 5) {
            const int bb_ = u.pm >> 3, m16b = 16 * (u.pm & 7) + 4 * wr;
            float rr[2][4];
#pragma unroll
            for (int ai = 0; ai < 2; ++ai)
#pragma unroll
                for (int m = 0; m < 4; ++m) rr[ai][m] = r0[row0 + ai * HALF + m * 16];
#pragma unroll
            for (int bj = 0; bj < 2; ++bj) { const int hh = (pn - 4) * 4 + 2 * bj + (wc >> 1);
                bf16_t* vb = VT16 + ((size_t)((bb_ * 8 + hh) * 64 + 32 * (wc & 1) + 8 * fq)) * SEQ + fr * 128 + m16b;
#pragma unroll
                for (int ai = 0; ai < 2; ++ai)
#pragma unroll
                    for (int n = 0; n < 2; ++n)
#pragma unroll
                        for (int i = 0; i < 4; ++i) { u32x2 w;
                            w.x = pk2(acc[ai][bj][0][n][i] * rr[ai][0], acc[ai][bj][1][n][i] * rr[ai][1]); w.y = pk2(acc[ai][bj][2][n][i] * rr[ai][2], acc[ai][bj][3][n][i] * rr[ai][3]);
                            *(u32x2*)(vb + (size_t)(4 * n + i) * SEQ + 8 * ai) = w; } }
        }
        const bool rot = (pn < 4) && ((wc & 1) == 0);
        const float qs = (pn < 2) ? 0.125f : 1.0f;
        const int col0 = pn * BM + wc * 32 + 8 * fq;
#pragma unroll
        for (int ai = 0; ai < 2; ++ai)
#pragma unroll
            for (int m = 0; m < 4; ++m) { const int row = row0 + ai * HALF + m * 16; const float r = r0[row] * qs;
                f32x4 c0 = {1.f, 1.f, 1.f, 1.f}, c1 = c0, s0 = {0.f, 0.f, 0.f, 0.f}, s1 = s0;
                if (rot) { const float* cp = cs + (size_t)row * 16; c0 = *(const f32x4*)cp; c1 = *(const f32x4*)(cp + 4); s0 = *(const f32x4*)(cp + 8); s1 = *(const f32x4*)(cp + 12);
                    if (fq == 0) { s0 = -s0; s1 = -s1; } else if (fq >= 2) { c0 = (f32x4){1.f, 1.f, 1.f, 1.f}; c1 = c0; s0 = (f32x4){0.f, 0.f, 0.f, 0.f}; s1 = s0; } }
#pragma unroll
                for (int bj = 0; bj < 2; ++bj) { f32x4 v0 = acc[ai][bj][m][0] * r, v1 = acc[ai][bj][m][1] * r;
                    if (rot) { f32x4 p0, p1;
#pragma unroll
                        for (int i = 0; i < 4; ++i) { p0[i] = __shfl_xor(v0[i], 16); p1[i] = __shfl_xor(v1[i], 16); }
                        v0 = v0 * c0 + p0 * s0; v1 = v1 * c1 + p1 * s1; }
                    u32x4 w; w.x = pk2(v0[0], v0[1]); w.y = pk2(v0[2], v0[3]); w.z = pk2(v1[0], v1[1]); w.w = pk2(v1[2], v1[3]);
                    *(u32x4*)(ZB + (size_t)row * ZW + col0 + bj * HALF) = w; } }
    }
};

template <bool BASE_BF16> struct EpiRes {
    static constexpr bool PERM = true;
    const float* basef; bf16_t* xb; float* ss;
    __device__ __forceinline__ void operator()(const AccT& acc, const Unit& u, int wr, int wc, int fr, int fq) const {
        const int row0 = u.pm * BM + wr * 64 + fr; const int col0 = u.pn * BM + wc * 32 + 8 * fq;
#pragma unroll
        for (int ai = 0; ai < 2; ++ai)
#pragma unroll
            for (int m = 0; m < 4; ++m) { const int row = row0 + ai * HALF + m * 16; float sq = 0.f;
#pragma unroll
                for (int bj = 0; bj < 2; ++bj) { const size_t off = (size_t)row * DM + col0 + bj * HALF;
                    f32x4 b0, b1;
                    if (BASE_BF16) { const u32x4 g = *(const u32x4*)(xb + off); b0 = (f32x4){bflo(g.x), bfhi(g.x), bflo(g.y), bfhi(g.y)}; b1 = (f32x4){bflo(g.z), bfhi(g.z), bflo(g.w), bfhi(g.w)}; }
                    else { b0 = *(const f32x4*)(basef + off); b1 = *(const f32x4*)(basef + off + 4); }
                    const f32x4 v0 = b0 + acc[ai][bj][m][0], v1 = b1 + acc[ai][bj][m][1];
                    u32x4 w; w.x = pk2(v0[0], v0[1]); w.y = pk2(v0[2], v0[3]); w.z = pk2(v1[0], v1[1]); w.w = pk2(v1[2], v1[3]);
                    *(u32x4*)(xb + off) = w;
                    sq += (v0[0] * v0[0] + v0[1] * v0[1]) + (v0[2] * v0[2] + v0[3] * v0[3]) + (v1[0] * v1[0] + v1[1] * v1[1]) + (v1[2] * v1[2] + v1[3] * v1[3]); }
                sq += __shfl_xor(sq, 16); sq += __shfl_xor(sq, 32);
                if (fq == 0) atomicAdd(ss + row, sq); }
    }
};

struct EpiGate {
    static constexpr bool PERM = true;
    bf16_t* GP; const float* ss;
    __device__ __forceinline__ void operator()(const AccT& acc, const Unit& u, int wr, int wc, int fr, int fq) const {
        const int row0 = u.pm * BM + wr * 64 + fr; const int col0 = u.pn * BM + wc * 32 + 8 * fq;
#pragma unroll
        for (int ai = 0; ai < 2; ++ai)
#pragma unroll
            for (int m = 0; m < 4; ++m) { const int row = row0 + ai * HALF + m * 16; const float r = rsqrtf(ss[row] * (1.0f / DM) + EPSF);
#pragma unroll
                for (int bj = 0; bj < 2; ++bj) { const f32x4 v0 = acc[ai][bj][m][0] * r, v1 = acc[ai][bj][m][1] * r;
                    u32x4 w; w.x = pk2(v0[0], v0[1]); w.y = pk2(v0[2], v0[3]); w.z = pk2(v1[0], v1[1]); w.w = pk2(v1[2], v1[3]);
                    *(u32x4*)(GP + (size_t)row * FF + col0 + bj * HALF) = w; } }
    }
};

struct EpiUp {
    static constexpr bool PERM = true;
    const bf16_t* GP; bf16_t* ACT; const float* ss; const float* cw; const float* cb;
    __device__ __forceinline__ void operator()(const AccT& acc, const Unit& u, int wr, int wc, int fr, int fq) const {
        const int row0 = u.pm * BM + wr * 64 + fr; const int col0 = u.pn * BM + wc * 32 + 8 * fq;
#pragma unroll
        for (int bj = 0; bj < 2; ++bj) { const int col = col0 + bj * HALF;
            f32x4 w0[2], w1[2], w2[2], bb[2];
#pragma unroll
            for (int n = 0; n < 2; ++n) { w0[n] = *(const f32x4*)(cw + col + 4 * n); w1[n] = *(const f32x4*)(cw + FF + col + 4 * n); w2[n] = *(const f32x4*)(cw + 2 * FF + col + 4 * n); bb[n] = *(const f32x4*)(cb + col + 4 * n); }
#pragma unroll
            for (int ai = 0; ai < 2; ++ai)
#pragma unroll
                for (int m = 0; m < 4; ++m) { const int row = row0 + ai * HALF + m * 16; const int s = row & (SEQ - 1); const float r = rsqrtf(ss[row] * (1.0f / DM) + EPSF);
                    const bf16_t* gp = GP + (size_t)row * FF + col;
                    const u32x4 gc = *(const u32x4*)gp;
                    u32x4 gm = {0u, 0u, 0u, 0u}, gn = {0u, 0u, 0u, 0u};
                    if (s > 0) gm = *(const u32x4*)(gp - FF);
                    if (s < SEQ - 1) gn = *(const u32x4*)(gp + FF);
                    float y[8];
#pragma unroll
                    for (int q = 0; q < 4; ++q) { const int n = q >> 1, i0 = (q & 1) * 2;
                        const float a0 = bflo(gm[q]) * w0[n][i0] + bflo(gc[q]) * w1[n][i0] + bflo(gn[q]) * w2[n][i0] + bb[n][i0];
                        const float a1 = bfhi(gm[q]) * w0[n][i0 + 1] + bfhi(gc[q]) * w1[n][i0 + 1] + bfhi(gn[q]) * w2[n][i0 + 1] + bb[n][i0 + 1];
                        y[2 * q] = gelu1(a0) * (acc[ai][bj][m][n][i0] * r); y[2 * q + 1] = gelu1(a1) * (acc[ai][bj][m][n][i0 + 1] * r); }
                    u32x4 w; w.x = pk2(y[0], y[1]); w.y = pk2(y[2], y[3]); w.z = pk2(y[4], y[5]); w.w = pk2(y[6], y[7]);
                    *(u32x4*)(ACT + (size_t)row * FF + col) = w; } }
    }
};

__device__ __forceinline__ float dpp_ror1(float v) { return __builtin_bit_cast(float, __builtin_amdgcn_update_dpp(0, __builtin_bit_cast(int, v), 0x121, 0xF, 0xF, false)); }
__device__ __forceinline__ float dpp_rol1(float v) { return __builtin_bit_cast(float, __builtin_amdgcn_update_dpp(0, __builtin_bit_cast(int, v), 0x12F, 0xF, 0xF, false)); }
struct EpiGU {
    static constexpr bool PERM = true;
    bf16_t* ACT; const float* ss; const float* cw; const float* cb; float* HALO; LAS float* E;
    __device__ __forceinline__ void operator()(const AccT& acc, const Unit& u, int wr, int wc, int fr, int fq) const {
        const int row0 = u.pm * BM + wr * 64 + fr; const int ecol = wc * 32 + 8 * fq; const int colg = u.pn * 128 + ecol;
        float rr[2][4];
#pragma unroll
        for (int ai = 0; ai < 2; ++ai)
#pragma unroll
            for (int m = 0; m < 4; ++m) rr[ai][m] = rsqrtf(ss[row0 + ai * HALF + m * 16] * (1.0f / DM) + EPSF);
#pragma unroll
        for (int ai = 0; ai < 2; ++ai) { const int k = 2 * ai + wr;
            if (fr == 0) { *(LAS f32x4*)(E + (k * 2 + 0) * 128 + ecol) = acc[ai][0][0][0] * rr[ai][0]; *(LAS f32x4*)(E + (k * 2 + 0) * 128 + ecol + 4) = acc[ai][0][0][1] * rr[ai][0]; }
            if (fr == 15) { *(LAS f32x4*)(E + (k * 2 + 1) * 128 + ecol) = acc[ai][0][3][0] * rr[ai][3]; *(LAS f32x4*)(E + (k * 2 + 1) * 128 + ecol + 4) = acc[ai][0][3][1] * rr[ai][3]; } }
        asm volatile("s_waitcnt lgkmcnt(0)" ::: "memory"); __builtin_amdgcn_s_barrier(); asm volatile("" ::: "memory");
        f32x4 w0[2], w1[2], w2[2], bb[2];
#pragma unroll
        for (int n = 0; n < 2; ++n) { w0[n] = *(const f32x4*)(cw + colg + 4 * n); w1[n] = *(const f32x4*)(cw + FF + colg + 4 * n); w2[n] = *(const f32x4*)(cw + 2 * FF + colg + 4 * n); bb[n] = *(const f32x4*)(cb + colg + 4 * n); }
#pragma unroll
        for (int ai = 0; ai < 2; ++ai) { const int k = 2 * ai + wr;
            f32x4 pe[2], ne[2];
#pragma unroll
            for (int n = 0; n < 2; ++n) { pe[n] = (f32x4){0.f, 0.f, 0.f, 0.f}; ne[n] = pe[n];
                if (k > 0) pe[n] = *(const LAS f32x4*)(E + ((k - 1) * 2 + 1) * 128 + ecol + 4 * n);
                if (k < 3) ne[n] = *(const LAS f32x4*)(E + ((k + 1) * 2 + 0) * 128 + ecol + 4 * n); }
            f32x4 g[4][2];
#pragma unroll
            for (int m = 0; m < 4; ++m)
#pragma unroll
                for (int n = 0; n < 2; ++n) g[m][n] = acc[ai][0][m][n] * rr[ai][m];
            f32x4 rorPrev[2] = {pe[0], pe[1]}, rolCur[2];
#pragma unroll
            for (int n = 0; n < 2; ++n)
#pragma unroll
                for (int i = 0; i < 4; ++i) rolCur[n][i] = dpp_rol1(g[0][n][i]);
#pragma unroll
            for (int m = 0; m < 4; ++m) { const int row = row0 + ai * HALF + m * 16;
                f32x4 pv[2], nv[2], rolNext[2];
#pragma unroll
                for (int n = 0; n < 2; ++n)
#pragma unroll
                    for (int i = 0; i < 4; ++i) { const float rc = dpp_ror1(g[m][n][i]); pv[n][i] = fr > 0 ? rc : rorPrev[n][i]; rorPrev[n][i] = rc;
                        rolNext[n][i] = (m < 3) ? dpp_rol1(g[m < 3 ? m + 1 : 3][n][i]) : ne[n][i]; nv[n][i] = fr < 15 ? rolCur[n][i] : rolNext[n][i]; rolCur[n][i] = rolNext[n][i]; }
                const bool top = (k == 0 && m == 0 && fr == 0), bot = (k == 3 && m == 3 && fr == 15);
                float y[8];
#pragma unroll
                for (int n = 0; n < 2; ++n) { const f32x4 uu = acc[ai][1][m][n] * rr[ai][m];
                    const f32x4 amid = g[m][n] * w1[n] + bb[n]; const f32x4 a = pv[n] * w0[n] + (amid + nv[n] * w2[n]);
#pragma unroll
                    for (int i = 0; i < 4; ++i) y[4 * n + i] = gelu1(a[i]) * uu[i];
                    if (top) { float* H = HALO + (size_t)((u.pm * 2 + 0) * 3) * FF + colg + 4 * n; *(f32x4*)H = g[m][n]; *(f32x4*)(H + FF) = amid + nv[n] * w2[n]; *(f32x4*)(H + 2 * FF) = uu; }
                    if (bot) { float* H = HALO + (size_t)((u.pm * 2 + 1) * 3) * FF + colg + 4 * n; *(f32x4*)H = g[m][n]; *(f32x4*)(H + FF) = pv[n] * w0[n] + amid; *(f32x4*)(H + 2 * FF) = uu; } }
                u32x4 w; w.x = pk2(y[0], y[1]); w.y = pk2(y[2], y[3]); w.z = pk2(y[4], y[5]); w.w = pk2(y[6], y[7]);
                *(u32x4*)(ACT + (size_t)row * FF + colg) = w; }
        }
    }
};

struct EpiStore {
    static constexpr bool PERM = true;
    bf16_t* O;
    __device__ __forceinline__ void operator()(const AccT& acc, const Unit& u, int wr, int wc, int fr, int fq) const {
        const int row0 = u.pm * BM + wr * 64 + fr; const int col0 = u.pn * BM + wc * 32 + 8 * fq;
#pragma unroll
        for (int ai = 0; ai < 2; ++ai)
#pragma unroll
            for (int m = 0; m < 4; ++m) { const int row = row0 + ai * HALF + m * 16;
#pragma unroll
                for (int bj = 0; bj < 2; ++bj) { const f32x4 v0 = acc[ai][bj][m][0], v1 = acc[ai][bj][m][1];
                    u32x4 w; w.x = pk2(v0[0], v0[1]); w.y = pk2(v0[2], v0[3]); w.z = pk2(v1[0], v1[1]); w.w = pk2(v1[2], v1[3]);
                    *(u32x4*)(O + (size_t)row * DM + col0 + bj * HALF) = w; } }
    }
};

struct EpiSigPle {
    static constexpr bool PERM = true;
    bf16_t* xb; const bf16_t* PP; const float* ssin; const float* bias; float* ss;
    __device__ __forceinline__ void operator()(const AccT& acc, const Unit& u, int wr, int wc, int fr, int fq) const {
        const int row0 = u.pm * BM + wr * 64 + fr; const int col0 = u.pn * BM + wc * 32 + 8 * fq;
#pragma unroll
        for (int ai = 0; ai < 2; ++ai)
#pragma unroll
            for (int m = 0; m < 4; ++m) { const int row = row0 + ai * HALF + m * 16; const float r = rsqrtf(ssin[row] * (1.0f / DM) + EPSF); float sq = 0.f;
#pragma unroll
                for (int bj = 0; bj < 2; ++bj) { const size_t off = (size_t)row * DM + col0 + bj * HALF;
                    const u32x4 xbv = *(const u32x4*)(xb + off); const u32x4 pv = __builtin_nontemporal_load((const u32x4*)(PP + off));
                    const f32x4 x0 = {bflo(xbv.x), bfhi(xbv.x), bflo(xbv.y), bfhi(xbv.y)}, x1 = {bflo(xbv.z), bfhi(xbv.z), bflo(xbv.w), bfhi(xbv.w)};
                    const f32x4 p0 = {bflo(pv.x), bfhi(pv.x), bflo(pv.y), bfhi(pv.y)}, p1 = {bflo(pv.z), bfhi(pv.z), bflo(pv.w), bfhi(pv.w)};
                    const f32x4 a0 = acc[ai][bj][m][0] * r + *(const f32x4*)(bias + col0 + bj * HALF), a1 = acc[ai][bj][m][1] * r + *(const f32x4*)(bias + col0 + bj * HALF + 4);
                    const f32x4 s0 = {sigmoidf_(a0[0]), sigmoidf_(a0[1]), sigmoidf_(a0[2]), sigmoidf_(a0[3])}, s1 = {sigmoidf_(a1[0]), sigmoidf_(a1[1]), sigmoidf_(a1[2]), sigmoidf_(a1[3])};
                    const f32x4 v0 = x0 + p0 * s0, v1 = x1 + p1 * s1;
                    u32x4 w; w.x = pk2(v0[0], v0[1]); w.y = pk2(v0[2], v0[3]); w.z = pk2(v1[0], v1[1]); w.w = pk2(v1[2], v1[3]);
                    *(u32x4*)(xb + off) = w;
                    sq += (v0[0] * v0[0] + v0[1] * v0[1]) + (v0[2] * v0[2] + v0[3] * v0[3]) + (v1[0] * v1[0] + v1[1] * v1[1]) + (v1[2] * v1[2] + v1[3] * v1[3]); }
                sq += __shfl_xor(sq, 16); sq += __shfl_xor(sq, 32);
                if (fq == 0) atomicAdd(ss + row, sq);
                asm volatile("" ::: "memory"); }
    }
};
}

__device__ __forceinline__ void transpose_item(const float* W, int K, int N, int nblk, const float* gk, bf16_t* WT, LAS float* scr, int item, int lane, int rowmode = 0) {
    const int kb = item / nblk, nb = item % nblk, k0 = 64 * kb, n0 = 32 * nb;
    const int d0 = rowmode == 0 ? n0 : (256 * (n0 >> 7) + (n0 & 127) + (rowmode == 2 ? 128 : 0));
    const int n = n0 + (lane & 31);
#pragma unroll 8
    for (int i = 0; i < 32; ++i) { const int kk = 2 * i + (lane >> 5); float v = 0.f; if (n < N) v = __builtin_nontemporal_load(&W[(size_t)(k0 + kk) * N + n]); if (gk) v *= gk[k0 + kk]; scr[kk * 33 + (lane & 31)] = v; }
    asm volatile("s_waitcnt lgkmcnt(0)" ::: "memory");
    const int c = lane & 7;
#pragma unroll
    for (int j = 0; j < 4; ++j) { const int nn = (lane >> 3) + 8 * j; const LAS float* s = scr + (8 * c) * 33 + nn;
        u32x4 o; o.x = pk2(s[0 * 33], s[1 * 33]); o.y = pk2(s[2 * 33], s[3 * 33]); o.z = pk2(s[4 * 33], s[5 * 33]); o.w = pk2(s[6 * 33], s[7 * 33]);
        *(u32x4*)(WT + (size_t)(d0 + nn) * K + k0 + 8 * c) = o; }
    asm volatile("s_waitcnt lgkmcnt(0)" ::: "memory");
}

__device__ __forceinline__ void phase_prologue(const Params& P, LAS unsigned char* lds, int G) {
    int tid = threadIdx.x; asm volatile("" : "+v"(tid));
    const int lane = tid & 63, wave = tid >> 6;
    const int gw = blockIdx.x * 8 + wave, NGW = G * 8;
    unsigned char* ws = P.ws;
    LAS float* scr = (LAS float*)(lds + wave * 16384);
    constexpr int I_IN = 16 * (NZPAD / 32), I_OUT = 16 * 32, I_G = 16 * (FF / 32), I_D = (FF / 64) * 32, I_PP = 4 * 32;
    constexpr int NITEMS = I_IN + I_OUT + 2 * I_G + I_D + I_OUT + I_PP;
    for (int it = gw; it < NITEMS; it += NGW) {
        int r = it;
        if (r < I_IN) { transpose_item(P.w_in, DM, NIN, NZPAD / 32, P.ln_mix_g, (bf16_t*)(ws + WS_WIN), scr, r, lane); continue; } r -= I_IN;
        if (r < I_OUT) { transpose_item(P.w_out, DM, DM, 32, nullptr, (bf16_t*)(ws + WS_WOUT), scr, r, lane); continue; } r -= I_OUT;
        if (r < I_G) { transpose_item(P.w_fg, DM, FF, FF / 32, P.ln_ffn_g, (bf16_t*)(ws + WS_WG), scr, r, lane, 1); continue; } r -= I_G;
        if (r < I_G) { transpose_item(P.w_fu, DM, FF, FF / 32, P.ln_ffn_g, (bf16_t*)(ws + WS_WG), scr, r, lane, 2); continue; } r -= I_G;
        if (r < I_D) { transpose_item(P.w_fd, FF, DM, 32, nullptr, (bf16_t*)(ws + WS_WD), scr, r, lane); continue; } r -= I_D;
        if (r < I_OUT) { transpose_item(P.w_pg, DM, DM, 32, P.ln_ple_g, (bf16_t*)(ws + WS_WPG), scr, r, lane); continue; } r -= I_OUT;
        transpose_item(P.w_pp, 256, DM, 32, nullptr, (bf16_t*)(ws + WS_WPP), scr, r, lane);
    }
    float* r0 = (float*)(ws + WS_R0); float* cs = (float*)(ws + WS_CS);
    bf16_t* XB = (bf16_t*)(ws + WS_XB); bf16_t* PB = (bf16_t*)(ws + WS_PB);
    for (int m0 = gw; m0 < MTOK; m0 += 2 * NGW) {
        const int m1 = (m0 + NGW < MTOK) ? m0 + NGW : m0;
        f32x4 v[2][4]; f32x4 pv[2]; int ps[2];
#pragma unroll
        for (int q = 0; q < 2; ++q) { const int m = q ? m1 : m0; const f32x4* xr = (const f32x4*)(P.x + (size_t)m * DM) + lane;
#pragma unroll
            for (int j = 0; j < 4; ++j) v[q][j] = __builtin_nontemporal_load(xr + 64 * j);
            pv[q] = __builtin_nontemporal_load((const f32x4*)(P.p + (size_t)m * 256) + lane); ps[q] = P.pos[m]; }
#pragma unroll
        for (int q = 0; q < 2; ++q) { const int m = q ? m1 : m0;
            if (q == 1 && m1 == m0) break;
            float s = 0.f;
#pragma unroll
            for (int j = 0; j < 4; ++j) s += (v[q][j].x * v[q][j].x + v[q][j].y * v[q][j].y) + (v[q][j].z * v[q][j].z + v[q][j].w * v[q][j].w);
            s = wave_sum(s);
            u32x2* o8 = (u32x2*)(XB + (size_t)m * DM) + lane;
#pragma unroll
            for (int j = 0; j < 4; ++j) { u32x2 w; w.x = pk2(v[q][j].x, v[q][j].y); w.y = pk2(v[q][j].z, v[q][j].w); o8[64 * j] = w; }
            if (lane == 0) r0[m] = rsqrtf(s * (1.0f / DM) + EPSF);
            u32x2 pw; pw.x = pk2(pv[q].x, pv[q].y); pw.y = pk2(pv[q].z, pv[q].w);
            *((u32x2*)(PB + (size_t)m * 256) + lane) = pw;
            if (lane < 8) {
                const double rev = (double)ps[q] * P.invrev[lane];
                const float fr = (float)(rev - floor(rev));
                cs[(size_t)m * 16 + lane] = __builtin_amdgcn_cosf(fr);
                cs[(size_t)m * 16 + 8 + lane] = __builtin_amdgcn_sinf(fr);
            } }
    }
    float* ssz = (float*)(ws + WS_SS1);
    for (int i = blockIdx.x * 512 + tid; i < 3 * MTOK; i += G * 512) ssz[i] = 0.f;
}

__device__ __forceinline__ void vtrans_unit(const Params& P, LAS unsigned char* lds, int unit) {
    int tid = threadIdx.x; asm volatile("" : "+v"(tid));
    const int blk = unit & 7, h = (unit >> 3) & 7, b = unit >> 6;
    const int s0 = blk * 256;
    unsigned char* ws = P.ws;
    const bf16_t* ZB = (const bf16_t*)(ws + WS_ZB);
    LAS bf16_t* tile = (LAS bf16_t*)lds;
    __syncthreads();
#pragma unroll
    for (int i = 0; i < 4; ++i) { const int ch = tid + 512 * i; const int t = ch >> 3, dc = ch & 7;
        const u32x4 v = *(const u32x4*)(ZB + (size_t)(b * SEQ + s0 + t) * ZW + 1024 + h * 64 + dc * 8);
        LAS unsigned* dst = (LAS unsigned*)(tile + t * 66 + dc * 8);
        dst[0] = v.x; dst[1] = v.y; dst[2] = v.z; dst[3] = v.w; }
    __syncthreads();
    const size_t hb = (size_t)((b * 8 + h) * 64) * SEQ;
    bf16_t* V1 = (bf16_t*)(ws + WS_VT1) + hb; bf16_t* V4 = (bf16_t*)(ws + WS_VT4) + hb; bf16_t* V16 = (bf16_t*)(ws + WS_VT16) + hb;
#pragma unroll
    for (int i = 0; i < 4; ++i) { const int ch = tid + 512 * i; const int d = ch >> 5, t8 = ch & 31;
        unsigned short e[8];
#pragma unroll
        for (int k = 0; k < 8; ++k) e[k] = tile[(t8 * 8 + k) * 66 + d];
        u32x4 w; w.x = e[0] | ((unsigned)e[1] << 16); w.y = e[2] | ((unsigned)e[3] << 16); w.z = e[4] | ((unsigned)e[5] << 16); w.w = e[6] | ((unsigned)e[7] << 16);
        *(u32x4*)(V1 + (size_t)d * SEQ + s0 + t8 * 8) = w; }
#pragma unroll
    for (int i = 0; i < 4; ++i) { const int ch = tid + 512 * i; const int d = ch >> 5, r = (ch >> 3) & 3, m8 = ch & 7;
        unsigned short e[8];
#pragma unroll
        for (int k = 0; k < 8; ++k) e[k] = tile[(4 * (m8 * 8 + k) + r) * 66 + d];
        u32x4 w; w.x = e[0] | ((unsigned)e[1] << 16); w.y = e[2] | ((unsigned)e[3] << 16); w.z = e[4] | ((unsigned)e[5] << 16); w.w = e[6] | ((unsigned)e[7] << 16);
        *(u32x4*)(V4 + (size_t)d * SEQ + r * 512 + (s0 >> 2) + m8 * 8) = w; }
#pragma unroll
    for (int i = 0; i < 4; ++i) { const int ch = tid + 512 * i; const int d = ch >> 5, r = (ch >> 1) & 15, m8 = ch & 1;
        unsigned short e[8];
#pragma unroll
        for (int k = 0; k < 8; ++k) e[k] = tile[(16 * (m8 * 8 + k) + r) * 66 + d];
        u32x4 w; w.x = e[0] | ((unsigned)e[1] << 16); w.y = e[2] | ((unsigned)e[3] << 16); w.z = e[4] | ((unsigned)e[5] << 16); w.w = e[6] | ((unsigned)e[7] << 16);
        *(u32x4*)(V16 + (size_t)d * SEQ + r * 128 + (s0 >> 4) + m8 * 8) = w; }
}

constexpr int SC_UC = 0, SC_P = 0  , SC_Q = 17408, SC_K = 34816, SC_KW = 52224, SC_VT = 70656, SC_CB = 91392, SC_F = 130560;
constexpr int NE = 144, NCT = 9;
__device__ __forceinline__ void scan_item(const Params& P, LAS unsigned char* lds, int item) {
    int tid = threadIdx.x; asm volatile("" : "+v"(tid));
    const int lane = tid & 63, w = __builtin_amdgcn_readfirstlane(tid >> 6), qi = lane & 15, quad = lane >> 4;
    const int dir = item & 1, h = (item >> 1) & 3, b = item >> 3;
    unsigned char* ws = P.ws;
    const bf16_t* ZB = (const bf16_t*)(ws + WS_ZB);
    const float* gates = (const float*)(ws + WS_GATES);
    bf16_t* HB = (bf16_t*)P.out + (dir ? (size_t)MTOK * 512 : 0);
    LAS bf16_t* ucS = (LAS bf16_t*)(lds + SC_UC); LAS bf16_t* qS = (LAS bf16_t*)(lds + SC_Q); LAS bf16_t* kS = (LAS bf16_t*)(lds + SC_K);
    LAS bf16_t* kwT = (LAS bf16_t*)(lds + SC_KW); LAS bf16_t* vT = (LAS bf16_t*)(lds + SC_VT); LAS bf16_t* pS = (LAS bf16_t*)(lds + SC_P); LAS bf16_t* CbT = (LAS bf16_t*)(lds + SC_CB);
    LAS float* cS = (LAS float*)(lds + SC_F); LAS float* MS = cS + 64; LAS float* aS = cS + 128; LAS float* eS = cS + 192; LAS float* wS = cS + 256; LAS float* denS = cS + 320; LAS float* misc = cS + 384;
    __syncthreads();
    bf16x8 wqf[4], wkf[4];
    {
        const float* wq = P.w_mq + (size_t)h * 128 * 128 + 16 * w + qi; const float* wk = P.w_mk + (size_t)h * 128 * 128 + 16 * w + qi;
        const float ksc = 0.08838834764831845f;
#pragma unroll
        for (int ks = 0; ks < 4; ++ks)
#pragma unroll
            for (int i = 0; i < 8; ++i) { const int d = ks * 32 + quad * 8 + i; wqf[ks][i] = (short)f2bf(wq[(size_t)d * 128]); wkf[ks][i] = (short)f2bf(wk[(size_t)d * 128] * ksc); }
    }
    for (int i = tid; i < NE * 136 / 2; i += 512) ((LAS unsigned*)CbT)[i] = 0u;
    for (int i = tid; i < 16 * 72; i += 512) vT[128 * 72 + i] = (i < 72) ? (bf16_t)0x3F80 : (bf16_t)0;
    f32x4 C[NCT];
#pragma unroll
    for (int ct = 0; ct < NCT; ++ct) C[ct] = (f32x4){0.f, 0.f, 0.f, 0.f};
    float m_run = 0.f;
    const float big = P.b_ig[dir * 4 + h], bfg = P.b_fg[dir * 4 + h];
    __syncthreads();
    u32x4 uc0, uc1, um0, um1, un0, un1, vvA, vvB; float pig = 0.f, pfg = 0.f;
#define SCAN_PREFETCH(cidx) do { const int cc_ = dir ? 31 - (cidx) : (cidx); const int t0_ = cc_ * 64; \
        { const int s_ = tid >> 3, dc_ = tid & 7; const int pos_ = dir ? t0_ + 63 - s_ : t0_ + s_; const size_t tok_ = (size_t)b * SEQ + pos_; \
          const bf16_t* up_ = ZB + tok_ * ZW + 1536 + h * 128 + dc_ * 16; \
          uc0 = *(const u32x4*)up_; uc1 = *(const u32x4*)(up_ + 8); \
          um0 = (u32x4){0u, 0u, 0u, 0u}; um1 = um0; un0 = um0; un1 = um0; \
          if (pos_ > 0) { um0 = *(const u32x4*)(up_ - ZW); um1 = *(const u32x4*)(up_ - ZW + 8); } \
          if (pos_ < SEQ - 1) { un0 = *(const u32x4*)(up_ + ZW); un1 = *(const u32x4*)(up_ + ZW + 8); } \
          vvA = *(const u32x4*)(ZB + tok_ * ZW + 2048 + h * 128 + dc_ * 16); vvB = *(const u32x4*)(ZB + tok_ * ZW + 2048 + h * 128 + dc_ * 16 + 8); } \
        if (w == 0) { const int pos_ = dir ? t0_ + 63 - lane : t0_ + lane; const size_t tok_ = (size_t)b * SEQ + pos_; \
          pig = gates[tok_ * 16 + dir * 4 + h]; pfg = gates[tok_ * 16 + 8 + dir * 4 + h]; } } while (0)
    SCAN_PREFETCH(0);
    for (int c = 0; c < 32; ++c) {
        const int cc = dir ? 31 - c : c; const int t0 = cc * 64;
        if (w == 0) {
            const float ig = pig + big; const float fg = pfg + bfg;
            const float lf = fminf(fg, 0.f) - log1pf(__expf(-fabsf(fg)));
            float bs = lf;
#pragma unroll
            for (int o = 1; o < 64; o <<= 1) { const float t = __shfl_up(bs, o); if (lane >= o) bs += t; }
            const float cv = ig - bs; float pm = cv;
#pragma unroll
            for (int o = 1; o < 64; o <<= 1) { const float t = __shfl_up(pm, o); if (lane >= o) pm = fmaxf(pm, t); }
            const float Mt = fmaxf(m_run, pm);
            const float M63 = __shfl(Mt, 63), g = __shfl(bs, 63);
            cS[lane] = cv; MS[lane] = Mt; aS[lane] = __expf(m_run - Mt); eS[lane] = __expf(-(bs + Mt)); wS[lane] = __expf(cv - M63);
            if (lane == 0) misc[0] = __expf(m_run - M63);
            m_run = g + M63;
        }
        {
            const int s = tid >> 3, dc = tid & 7; const int pos = dir ? t0 + 63 - s : t0 + s; const size_t tok = (size_t)b * SEQ + pos;
            const int ch = h * 128 + dc * 16;
            unsigned ow[8];
#pragma unroll
            for (int q = 0; q < 8; ++q) { const unsigned m_ = q < 4 ? um0[q & 3] : um1[q & 3], c_ = q < 4 ? uc0[q & 3] : uc1[q & 3], n_ = q < 4 ? un0[q & 3] : un1[q & 3];
                const int cch = ch + 2 * q;
                const float a0 = bflo(m_) * P.mconv_w[cch] + bflo(c_) * P.mconv_w[512 + cch] + bflo(n_) * P.mconv_w[1024 + cch] + P.mconv_b[cch];
                const float a1 = bfhi(m_) * P.mconv_w[cch + 1] + bfhi(c_) * P.mconv_w[512 + cch + 1] + bfhi(n_) * P.mconv_w[1024 + cch + 1] + P.mconv_b[cch + 1];
                ow[q] = pk2(a0 * sigmoidf_(a0), a1 * sigmoidf_(a1)); }
            LAS u32x4* dst = (LAS u32x4*)(ucS + s * 136 + dc * 16);
            dst[0] = (u32x4){ow[0], ow[1], ow[2], ow[3]}; dst[1] = (u32x4){ow[4], ow[5], ow[6], ow[7]};
            const int e0 = dc * 16;
            const int sc_ = (s + 8 * dc) & 63;
#pragma unroll
            for (int q = 0; q < 4; ++q) { const unsigned wa = vvA[q], wb = vvB[q];
                vT[(e0 + 2 * q) * 72 + sc_] = (bf16_t)(wa & 0xffff); vT[(e0 + 2 * q + 1) * 72 + sc_] = (bf16_t)(wa >> 16);
                vT[(e0 + 8 + 2 * q) * 72 + sc_] = (bf16_t)(wb & 0xffff); vT[(e0 + 8 + 2 * q + 1) * 72 + sc_] = (bf16_t)(wb >> 16); }
        }
        __syncthreads();
        { const int cn = c < 31 ? c + 1 : 31; SCAN_PREFETCH(cn); }
#pragma unroll
        for (int st = 0; st < 4; ++st) {
            f32x4 aq = {0.f, 0.f, 0.f, 0.f}, ak = aq;
            const int s = st * 16 + qi;
#pragma unroll
            for (int ks = 0; ks < 4; ++ks) { const bf16x8 uf = *(const LAS bf16x8*)(ucS + s * 136 + ks * 32 + quad * 8);
                aq = __builtin_amdgcn_mfma_f32_16x16x32_bf16(wqf[ks], uf, aq, 0, 0, 0); ak = __builtin_amdgcn_mfma_f32_16x16x32_bf16(wkf[ks], uf, ak, 0, 0, 0); }
            const int e = 16 * w + quad * 4;
            u32x2 qw; qw.x = pk2(aq[0], aq[1]); qw.y = pk2(aq[2], aq[3]); *(LAS u32x2*)(qS + s * 136 + e) = qw;
            u32x2 kw; kw.x = pk2(ak[0], ak[1]); kw.y = pk2(ak[2], ak[3]); *(LAS u32x2*)(kS + s * 136 + e) = kw;
            const float wsv = wS[s];
#pragma unroll
            for (int j = 0; j < 4; ++j) kwT[(e + j) * 72 + s] = (bf16_t)f2bf(ak[j] * wsv);
        }
        __syncthreads();
        {
            const int tt = w >> 1; const int t = tt * 16 + qi; const float Mt = MS[t];
#pragma unroll
            for (int si = 0; si < 2; ++si) { const int st = (w & 1) * 2 + si; const int srow = st * 16 + qi;
                f32x4 sa = {0.f, 0.f, 0.f, 0.f};
#pragma unroll
                for (int ks = 0; ks < 4; ++ks) { const bf16x8 kf = *(const LAS bf16x8*)(kS + srow * 136 + ks * 32 + quad * 8); const bf16x8 qf = *(const LAS bf16x8*)(qS + t * 136 + ks * 32 + quad * 8);
                    sa = __builtin_amdgcn_mfma_f32_16x16x32_bf16(kf, qf, sa, 0, 0, 0); }
                float pv[4];
#pragma unroll
                for (int j = 0; j < 4; ++j) { const int s = st * 16 + quad * 4 + j; pv[j] = (s <= t) ? sa[j] * __expf(cS[s] - Mt) : 0.f; }
                u32x2 pw; pw.x = pk2(pv[0], pv[1]); pw.y = pk2(pv[2], pv[3]); *(LAS u32x2*)(pS + t * 72 + st * 16 + quad * 4) = pw; }
        }
        __syncthreads();
        {
            const int tt = w >> 1; const int t = tt * 16 + qi; const float at = aS[t];
            const int ct0 = (w & 1) ? 5 : 0; const int nct = (w & 1) ? 4 : 5;
            f32x4 na[5];
#pragma unroll
            for (int ci = 0; ci < 5; ++ci) { na[ci] = (f32x4){0.f, 0.f, 0.f, 0.f};
                if (ci < nct) { const int ep = (ct0 + ci) * 16 + qi;
#pragma unroll
                    for (int ks = 0; ks < 4; ++ks) { const bf16x8 cf = *(const LAS bf16x8*)(CbT + ep * 136 + ks * 32 + quad * 8); const bf16x8 qf = *(const LAS bf16x8*)(qS + t * 136 + ks * 32 + quad * 8);
                        na[ci] = __builtin_amdgcn_mfma_f32_16x16x32_bf16(cf, qf, na[ci], 0, 0, 0); }
                    na[ci] = na[ci] * at;
#pragma unroll
                    for (int ks = 0; ks < 2; ++ks) { const bf16x8 vf = *(const LAS bf16x8*)(vT + ep * 72 + ((ks * 32 + quad * 8 + 8 * (ep >> 4)) & 63)); const bf16x8 pf = *(const LAS bf16x8*)(pS + t * 72 + ks * 32 + quad * 8);
                        na[ci] = __builtin_amdgcn_mfma_f32_16x16x32_bf16(vf, pf, na[ci], 0, 0, 0); } } }
            if ((w & 1) && quad == 0) denS[t] = na[3][0];
            __syncthreads();
            const float den = denS[t]; const float dn = fmaxf(fabsf(den), eS[t]); const float inv = 1.0f / dn;
            const int pos = dir ? t0 + 63 - t : t0 + t; const size_t tok = (size_t)b * SEQ + pos;
#pragma unroll
            for (int ci = 0; ci < 5; ++ci) { const int ct = ct0 + ci;
                if (ci < nct && ct < 8) { u32x2 hw; hw.x = pk2(na[ci][0] * inv, na[ci][1] * inv); hw.y = pk2(na[ci][2] * inv, na[ci][3] * inv);
                    *(u32x2*)(HB + tok * 512 + h * 128 + ct * 16 + quad * 4) = hw; } }
        }
        {
            const float decay = misc[0];
            const int drow = 16 * w + qi;
            bf16x8 kf[2];
#pragma unroll
            for (int ks = 0; ks < 2; ++ks) kf[ks] = *(const LAS bf16x8*)(kwT + drow * 72 + ks * 32 + quad * 8);
#pragma unroll
            for (int ct = 0; ct < NCT; ++ct) { C[ct] = C[ct] * decay;
#pragma unroll
                for (int ks = 0; ks < 2; ++ks) { const bf16x8 vf = *(const LAS bf16x8*)(vT + (ct * 16 + qi) * 72 + ((ks * 32 + quad * 8 + 8 * ct) & 63));
                    C[ct] = __builtin_amdgcn_mfma_f32_16x16x32_bf16(kf[ks], vf, C[ct], 0, 0, 0); }
                u32x2 cw; cw.x = pk2(C[ct][0], C[ct][1]); cw.y = pk2(C[ct][2], C[ct][3]);
                *(LAS u32x2*)(CbT + (ct * 16 + qi) * 136 + 16 * w + quad * 4) = cw; }
        }
        __syncthreads();
    }
}

__device__ __forceinline__ int iclamp(int v, int lo, int hi) { return v < lo ? lo : (v > hi ? hi : v); }
__device__ __forceinline__ void attn_step(const bf16x8 (&kf)[2][2], const bf16x8 (&vf)[4], const bf16x8 (&qf)[2], f32x4 (&o)[4], float& mrun, float& lrun,
                                          int k0, int M, int mq, int quad) {
    f32x4 sa[2];
#pragma unroll
    for (int T = 0; T < 2; ++T) { sa[T] = (f32x4){0.f, 0.f, 0.f, 0.f};
        sa[T] = __builtin_amdgcn_mfma_f32_16x16x32_bf16(kf[T][0], qf[0], sa[T], 0, 0, 0);
        sa[T] = __builtin_amdgcn_mfma_f32_16x16x32_bf16(kf[T][1], qf[1], sa[T], 0, 0, 0); }
    float sc[8]; float mx = -1e30f;
#pragma unroll
    for (int T = 0; T < 2; ++T)
#pragma unroll
        for (int jj = 0; jj < 4; ++jj) { const int kk = k0 + 8 * quad + 4 * T + jj; const int dq = kk - mq;
            const bool valid = (kk >= 0) && (kk < M) && (dq >= -64) && (dq <= 64);
            const float sv = valid ? sa[T][jj] : -1e30f; sc[T * 4 + jj] = sv; mx = fmaxf(mx, sv); }
    mx = fmaxf(mx, __shfl_xor(mx, 16)); mx = fmaxf(mx, __shfl_xor(mx, 32));
    const float mnew = fmaxf(mrun, mx); const float scale = __expf(mrun - mnew); mrun = mnew;
    float ps[8]; float lsum = 0.f;
#pragma unroll
    for (int i = 0; i < 8; ++i) { ps[i] = __expf(sc[i] - mnew); lsum += ps[i]; }
    lrun = lrun * scale + lsum;
    const u32x4 pwv = {pk2(ps[0], ps[1]), pk2(ps[2], ps[3]), pk2(ps[4], ps[5]), pk2(ps[6], ps[7])};
    const bf16x8 pf = __builtin_bit_cast(bf16x8, pwv);
#pragma unroll
    for (int dt = 0; dt < 4; ++dt) { o[dt] = o[dt] * scale; o[dt] = __builtin_amdgcn_mfma_f32_16x16x32_bf16(vf[dt], pf, o[dt], 0, 0, 0); }
}

constexpr int AT_KS = 0, AT_VS = 55296;
__device__ __forceinline__ void attn_unit(const Params& P, LAS unsigned char* lds, int b, int h, int blk, int tid) {
    const int lane = tid & 63, wave = tid >> 6, qi = lane & 15, quad = lane >> 4;
    const int krow = 8 * (qi >> 2) + (qi & 3);
    unsigned char* ws = P.ws;
    const bf16_t* ZB = (const bf16_t*)(ws + WS_ZB);
    bf16_t* MIX = (bf16_t*)(ws + WS_MIX);
    const int s0 = blk * 256;
    const size_t hb = (size_t)((b * 8 + h) * 64) * SEQ;
    LAS bf16_t* Ks = (LAS bf16_t*)(lds + AT_KS); LAS bf16_t* Vs = (LAS bf16_t*)(lds + AT_VS);
    __syncthreads();
    {
        int tl = tid; asm volatile("" : "+v"(tl));
#pragma unroll
        for (int i = 0; i < 6; ++i) { const int c = tl + 512 * i; const int row = c >> 3, ch = c & 7; const int pos = s0 - 64 + row;
            u32x4 kv = {0u, 0u, 0u, 0u}, vv = kv;
            if (pos >= 0 && pos < SEQ) { const bf16_t* zp = ZB + ((size_t)b * SEQ + pos) * ZW + h * 64 + ch * 8; kv = *(const u32x4*)(zp + 512); vv = *(const u32x4*)(zp + 1024); }
            *(LAS u32x4*)(Ks + row * 72 + ch * 8) = kv;
            const int colw = row + 8 * ch; LAS bf16_t* vd = Vs + (ch * 8) * 392 + (colw >= 384 ? colw - 384 : colw);
            vd[0 * 392] = (bf16_t)(vv.x & 0xffff); vd[1 * 392] = (bf16_t)(vv.x >> 16); vd[2 * 392] = (bf16_t)(vv.y & 0xffff); vd[3 * 392] = (bf16_t)(vv.y >> 16);
            vd[4 * 392] = (bf16_t)(vv.z & 0xffff); vd[5 * 392] = (bf16_t)(vv.z >> 16); vd[6 * 392] = (bf16_t)(vv.w & 0xffff); vd[7 * 392] = (bf16_t)(vv.w >> 16); }
    }
    int jj2[2], posq[2]; size_t tokq[2];
    bf16x8 qf[2][2]; f32x4 o[2][4]; float mrun[2], lrun[2];
#pragma unroll
    for (int t = 0; t < 2; ++t) { jj2[t] = 4 * (wave >> 1) + (wave & 1) + 2 * t;     posq[t] = s0 + jj2[t] + 16 * qi; tokq[t] = (size_t)b * SEQ + posq[t];
#pragma unroll
        for (int ks = 0; ks < 2; ++ks) qf[t][ks] = *(const bf16x8*)(ZB + tokq[t] * ZW + h * 64 + ks * 32 + quad * 8);
#pragma unroll
        for (int dt = 0; dt < 4; ++dt) o[t][dt] = (f32x4){0.f, 0.f, 0.f, 0.f};
        mrun[t] = -1e30f; lrun[t] = 0.f; }
    const bf16_t* Kb = ZB + (size_t)b * SEQ * ZW + 512 + h * 64 + quad * 8;
    {
        const int dil = 16, M = 128; int r[2], mq[2]; const bf16_t* VT[2];
#pragma unroll
        for (int t = 0; t < 2; ++t) { r[t] = jj2[t]; mq[t] = blk * 16 + qi; VT[t] = (const bf16_t*)(ws + WS_VT16) + hb + r[t] * 128; }
#pragma unroll 1
        for (int st = 0; st < 2; ++st) {
            const int k0 = st * 64;
#pragma unroll
            for (int t = 0; t < 2; ++t) {
                bf16x8 kf[2][2][2], vf[2][4];
#pragma unroll
                for (int hs = 0; hs < 2; ++hs) {
#pragma unroll
                    for (int T = 0; T < 2; ++T) { const int kc = iclamp(k0 + 32 * hs + krow + 4 * T, 0, M - 1); const bf16_t* kp = Kb + (size_t)(r[t] + dil * kc) * ZW;
                        kf[hs][T][0] = *(const bf16x8*)kp; kf[hs][T][1] = *(const bf16x8*)(kp + 32); }
                    const int g = iclamp(k0 + 32 * hs + 8 * quad, 0, M - 8);
#pragma unroll
                    for (int dt = 0; dt < 4; ++dt) vf[hs][dt] = *(const bf16x8*)(VT[t] + (size_t)(dt * 16 + qi) * SEQ + g);
                }
#pragma unroll
                for (int hs = 0; hs < 2; ++hs) attn_step(kf[hs], vf[hs], qf[t], o[t], mrun[t], lrun[t], k0 + 32 * hs, M, mq[t], quad);
                __builtin_amdgcn_sched_barrier(0);
            }
        }
    }
    __syncthreads();
#pragma unroll 1
    for (int st = 0; st < 12; ++st) {
        const int kl = st * 32, k0 = s0 - 64 + kl;
        bf16x8 kf[2][2], vf[4];
#pragma unroll
        for (int T = 0; T < 2; ++T)
#pragma unroll
            for (int ks = 0; ks < 2; ++ks) kf[T][ks] = *(const LAS bf16x8*)(Ks + (kl + krow + 4 * T) * 72 + ks * 32 + quad * 8);
#pragma unroll
        for (int dt = 0; dt < 4; ++dt) { const int colr = kl + 8 * quad + 8 * (2 * dt + (qi >> 3)); vf[dt] = *(const LAS bf16x8*)(Vs + (dt * 16 + qi) * 392 + (colr >= 384 ? colr - 384 : colr)); }
#pragma unroll
        for (int t = 0; t < 2; ++t) attn_step(kf, vf, qf[t], o[t], mrun[t], lrun[t], k0, SEQ, posq[t], quad);
    }
    {
        LAS bf16_t* K4s = (LAS bf16_t*)(lds + AT_KS); LAS bf16_t* V4s = (LAS bf16_t*)(lds + AT_VS);
        const int m0 = blk * 64 - 64;
#pragma unroll
        for (int p = 0; p < 2; ++p) {
            __syncthreads();
            int tl = tid; asm volatile("" : "+v"(tl));
#pragma unroll
            for (int i = 0; i < 6; ++i) { const int c = tl + 512 * i; const int cl = c >= 1536 ? 1 : 0; const int rem = c - cl * 1536;
                const int row = rem >> 3, ch = rem & 7; const int m = m0 + row;
                u32x4 kv = {0u, 0u, 0u, 0u}, vv = kv;
                if (m >= 0 && m < 512) { const bf16_t* zp = ZB + ((size_t)b * SEQ + 4 * m + 2 * p + cl) * ZW + h * 64 + ch * 8; kv = *(const u32x4*)(zp + 512); vv = *(const u32x4*)(zp + 1024); }
                *(LAS u32x4*)(K4s + (cl * 192 + row) * 72 + ch * 8) = kv;
                const int colw = row + 8 * ch; LAS bf16_t* vd = V4s + (cl * 64 + ch * 8) * 200 + (colw >= 192 ? colw - 192 : colw);
                vd[0 * 200] = (bf16_t)(vv.x & 0xffff); vd[1 * 200] = (bf16_t)(vv.x >> 16); vd[2 * 200] = (bf16_t)(vv.y & 0xffff); vd[3 * 200] = (bf16_t)(vv.y >> 16);
                vd[4 * 200] = (bf16_t)(vv.z & 0xffff); vd[5 * 200] = (bf16_t)(vv.z >> 16); vd[6 * 200] = (bf16_t)(vv.w & 0xffff); vd[7 * 200] = (bf16_t)(vv.w >> 16); }
            __syncthreads();
            const int cl = (jj2[p] & 3) - 2 * p; const int mq = blk * 64 + (jj2[p] >> 2) + 4 * qi;
#pragma unroll 1
            for (int st = 0; st < 6; ++st) {
                const int kl = st * 32;
                bf16x8 kf[2][2], vf[4];
#pragma unroll
                for (int T = 0; T < 2; ++T)
#pragma unroll
                    for (int ks = 0; ks < 2; ++ks) kf[T][ks] = *(const LAS bf16x8*)(K4s + (cl * 192 + kl + krow + 4 * T) * 72 + ks * 32 + quad * 8);
#pragma unroll
                for (int dt = 0; dt < 4; ++dt) { const int colr = kl + 8 * quad + 8 * (2 * dt + (qi >> 3)); vf[dt] = *(const LAS bf16x8*)(V4s + (cl * 64 + dt * 16 + qi) * 200 + (colr >= 192 ? colr - 192 : colr)); }
                attn_step(kf, vf, qf[p], o[p], mrun[p], lrun[p], m0 + kl, 512, mq, quad);
            }
        }
    }
#pragma unroll
    for (int t = 0; t < 2; ++t) {
        float l = lrun[t]; l += __shfl_xor(l, 16); l += __shfl_xor(l, 32);
        const float inv = 1.0f / l;
#pragma unroll
        for (int dt = 0; dt < 4; ++dt) { u32x2 w; w.x = pk2(o[t][dt][0] * inv, o[t][dt][1] * inv); w.y = pk2(o[t][dt][2] * inv, o[t][dt][3] * inv);
            *(u32x2*)(MIX + tokq[t] * DM + h * 64 + dt * 16 + quad * 4) = w; }
    }
}

__device__ __forceinline__ void mlstm_post_row(const Params& P, int tok, int lane) {
    unsigned char* ws = P.ws;
    const bf16_t* HF = (const bf16_t*)P.out; const bf16_t* HBk = (const bf16_t*)P.out + (size_t)MTOK * 512; const bf16_t* ZB = (const bf16_t*)(ws + WS_ZB); bf16_t* MIX = (bf16_t*)(ws + WS_MIX);
    const u32x4 a = __builtin_nontemporal_load((const u32x4*)(HF + (size_t)tok * 512 + lane * 8)), c = __builtin_nontemporal_load((const u32x4*)(HBk + (size_t)tok * 512 + lane * 8));
    float v[8];
#pragma unroll
    for (int q = 0; q < 4; ++q) { v[2 * q] = bflo(a[q]) + bflo(c[q]); v[2 * q + 1] = bfhi(a[q]) + bfhi(c[q]); }
    float s = 0.f;
#pragma unroll
    for (int i = 0; i < 8; ++i) s += v[i];
#pragma unroll
    for (int o = 1; o < 16; o <<= 1) s += __shfl_xor(s, o);
    const float mu = s * (1.0f / 128.0f); float q2 = 0.f;
#pragma unroll
    for (int i = 0; i < 8; ++i) { v[i] -= mu; q2 += v[i] * v[i]; }
#pragma unroll
    for (int o = 1; o < 16; o <<= 1) q2 += __shfl_xor(q2, o);
    const float rs = rsqrtf(q2 * (1.0f / 128.0f) + EPSF);
    const u32x4 og = __builtin_nontemporal_load((const u32x4*)(ZB + (size_t)tok * ZW + 2560 + lane * 8));
    const f32x4 g0 = *(const f32x4*)(P.gn_g + lane * 8), g1 = *(const f32x4*)(P.gn_g + lane * 8 + 4);
    float y[8];
#pragma unroll
    for (int q = 0; q < 4; ++q) { const float o0 = bflo(og[q]), o1 = bfhi(og[q]); const float gg0 = q < 2 ? g0[2 * q] : g1[2 * q - 4], gg1 = q < 2 ? g0[2 * q + 1] : g1[2 * q - 3];
        y[2 * q] = v[2 * q] * rs * gg0 * sigmoidf_(o0); y[2 * q + 1] = v[2 * q + 1] * rs * gg1 * sigmoidf_(o1); }
    u32x4 w; w.x = pk2(y[0], y[1]); w.y = pk2(y[2], y[3]); w.z = pk2(y[4], y[5]); w.w = pk2(y[6], y[7]);
    *(u32x4*)(MIX + (size_t)tok * DM + 512 + lane * 8) = w;
}


#define XB_TMO      128
#define XB_XCNT(j)  (256  + 64 * (j))
#define XB_XSUB(j)  (1280 + 64 * (j))
#define XB_XGEN(j)  (2304 + 64 * (j))
#define XB_TOP      3328
#define XB_TOPGEN   3392
#define XCD_BAR_WORDS 3456
#define XB_SPIN_CAP (1u << 20)
__device__ __forceinline__ unsigned xb_ld(unsigned* p)              { return __hip_atomic_load(p, __ATOMIC_RELAXED, __HIP_MEMORY_SCOPE_AGENT); }
__device__ __forceinline__ unsigned xb_add(unsigned* p, unsigned v) { return __hip_atomic_fetch_add(p, v, __ATOMIC_RELAXED, __HIP_MEMORY_SCOPE_AGENT); }
__device__ __forceinline__ unsigned xb_xcc_id() { return (unsigned)__builtin_amdgcn_s_getreg((3 << 11) | 20) & 0xFu; }
#define XB_SPIN(cond, bar) do { unsigned _sp = 0; while (cond) { __builtin_amdgcn_s_sleep(1); \
    if ((++_sp & 255u) == 0u) { if (xb_ld(&(bar)[XB_TMO])) break; if (_sp > XB_SPIN_CAP) { atomicAdd(&(bar)[XB_TMO], 1u); break; } } } } while (0)
struct XcdBarrier { unsigned* bar; unsigned x; volatile LAS unsigned* st; };
__device__ __forceinline__ XcdBarrier xcd_barrier_post(unsigned* bar, volatile LAS unsigned* st) {
    XcdBarrier b; b.bar = bar; b.x = xb_xcc_id(); b.st = st;
    if (threadIdx.x == 0) (void)xb_add(&bar[XB_XCNT(b.x)], 1u);
    return b;
}
__device__ __forceinline__ void xcd_barrier_complete(unsigned* bar, unsigned x, unsigned& nloc, unsigned& nx) {
    const unsigned G = gridDim.x * gridDim.y * gridDim.z;
    unsigned sum, cnt, mine, sp = 0u;
    for (;;) {
        sum = 0u; cnt = 0u; mine = 0u;
#pragma unroll
        for (unsigned j = 0; j < 16; ++j) { const unsigned c = xb_ld(&bar[XB_XCNT(j)]); sum += c; cnt += (c > 0u) ? 1u : 0u; mine = (j == x) ? c : mine; }
        if (sum == G) break;
        __builtin_amdgcn_s_sleep(1);
        if ((++sp & 255u) == 0u) { if (xb_ld(&bar[XB_TMO])) break; if (sp > XB_SPIN_CAP) { atomicAdd(&bar[XB_TMO], 1u); break; } }
    }
    nloc = mine > 0u ? mine : 1u; nx = cnt > 0u ? cnt : 1u;
}
__device__ __forceinline__ void xcd_barrier(const XcdBarrier& b) {
    asm volatile("s_waitcnt vmcnt(0)" ::: "memory");
    __syncthreads();
    if (threadIdx.x == 0) {
        unsigned* bar = b.bar;
        __builtin_amdgcn_s_waitcnt(0);
        unsigned nloc = b.st[0], nx = b.st[1];
        if (nloc == 0u) { xcd_barrier_complete(bar, b.x, nloc, nx); b.st[0] = nloc; b.st[1] = nx; }
        const unsigned old = xb_add(&bar[XB_XSUB(b.x)], 1u);
        const unsigned gen = old / nloc;
        if (old + 1u == (gen + 1u) * nloc) {
            __builtin_amdgcn_fence(__ATOMIC_RELEASE, "agent");
            asm volatile("s_waitcnt vmcnt(0)" ::: "memory");
            const unsigned og = xb_add(&bar[XB_TOP], 1u);
            const unsigned tg = og / nx;
            if (og + 1u == (tg + 1u) * nx) xb_add(&bar[XB_TOPGEN], 1u);
            else XB_SPIN(xb_ld(&bar[XB_TOPGEN]) == tg, bar);
            __builtin_amdgcn_fence(__ATOMIC_ACQUIRE, "agent");
            xb_add(&bar[XB_XGEN(b.x)], 1u);
            asm volatile("s_waitcnt vmcnt(0)" ::: "memory");
        } else {
            XB_SPIN(xb_ld(&bar[XB_XGEN(b.x)]) == gen, bar);
            __builtin_amdgcn_fence(__ATOMIC_ACQUIRE, "agent");
            asm volatile("s_waitcnt vmcnt(0)" ::: "memory");
        }
    }
    __syncthreads();
}
#define GRID_SYNC() xcd_barrier(xbar)
__global__ void __launch_bounds__(512) fwd_megakernel(Params P) {
    extern __shared__ __attribute__((aligned(16))) unsigned char lds_raw[];
    LAS unsigned char* lds = (LAS unsigned char*)lds_raw;
    cg::grid_group grid = cg::this_grid();
    const int G = gridDim.x, bid = blockIdx.x;
    unsigned char* ws = P.ws;
    if (G == 0x7fffffff) grid.sync();
    { volatile LAS unsigned* stw = (volatile LAS unsigned*)(lds + LDS_ST_OFF); if (threadIdx.x < 4) stw[threadIdx.x] = 0u; }
    __syncthreads();
    const XcdBarrier xbar = xcd_barrier_post((unsigned*)(ws + WS_BAR), (volatile LAS unsigned*)(lds + LDS_ST_OFF));

    for (int rep = 0; rep < REP_MISC; ++rep) phase_prologue(P, lds, G);
    GRID_SYNC();
    {
        pg8::Gemm g{(const bf16_t*)(ws + WS_XB), (const bf16_t*)(ws + WS_WIN), MTOK, NZPAD, DM}; pg8::StaticOrder S; S.init(MTOK, NZPAD, G, bid);
        pg8::EpiZ E{(bf16_t*)(ws + WS_ZB), (float*)(ws + WS_GATES), (const float*)(ws + WS_R0), (const float*)(ws + WS_CS), (bf16_t*)(ws + WS_VT16)};
        for (int rep = 0; rep < REP_G; ++rep) pg8::gemm_phase<pg8::EpiZ, true>(lds, g, S, E);
    }
    GRID_SYNC();
#ifdef PROBE_STOP
    if (PROBE_STOP == 1) {
        int tid = threadIdx.x; asm volatile("" : "+v"(tid));
        for (size_t i = (size_t)bid * 512 + tid; i < (size_t)MTOK * DM; i += (size_t)G * 512) {
            const size_t m = i >> 10, c = i & 1023; float v;
            if (PROBE_STOP == 1) { const bf16_t* ZBp = (const bf16_t*)(ws + WS_ZB); v = bf1(ZBp[m * ZW + c]) + bf1(ZBp[m * ZW + c + 1024]) + bf1(ZBp[m * ZW + c + 2048]) + ((const float*)(ws + WS_GATES))[m * 16 + (c & 15)]; }
            else if (PROBE_STOP == 2) { v =
#ifndef PROBE_NOSCAN
 bf1(((const bf16_t*)(ws + WS_HF))[m * 512 + (c & 511)]) + bf1(((const bf16_t*)(ws + WS_HB))[m * 512 + (c & 511)]) +
#endif
 bf1(((const bf16_t*)(ws + WS_VT1))[i]) + bf1(((const bf16_t*)(ws + WS_VT4))[i]) + bf1(((const bf16_t*)(ws + WS_VT16))[i]); }
            else { v = bf1(((const bf16_t*)(ws + WS_MIX))[i]); }
            if (!(fabsf(v) < 1e30f)) v = 12345.f;
            P.out[i] = v; }
        return;
    }
#endif
    {
        int tid = threadIdx.x; asm volatile("" : "+v"(tid));
        const int nscan = G >= 256 ? 128 : (G > 1 ? G / 2 : 1);
        if (G == 256) { if ((bid & 7) < 4) scan_item(P, lds, (bid >> 3) * 4 + (bid & 3)); }
        else if (bid < nscan) for (int it = bid; it < 128; it += nscan) scan_item(P, lds, it);
        unsigned* queue = (unsigned*)(ws + WS_BAR) + 3520;
        volatile LAS unsigned* qw = (volatile LAS unsigned*)(lds + LDS_ST_OFF + 16);
        for (;;) {
            __syncthreads();
            if (tid == 0) qw[0] = __hip_atomic_fetch_add(queue, 1u, __ATOMIC_RELAXED, __HIP_MEMORY_SCOPE_AGENT);
            __syncthreads();
            const int u = (int)qw[0];
            if (u >= NB * 8 * 8) break;
            attn_unit(P, lds, u >> 6, (u >> 3) & 7, u & 7, tid);
        }
    }
    GRID_SYNC();
    {
        int tid = threadIdx.x; asm volatile("" : "+v"(tid));
        const int lane = tid & 63, wave = tid >> 6;
        for (int tok = bid * 8 + wave; tok < MTOK; tok += G * 8) mlstm_post_row(P, tok, lane);
    }
    GRID_SYNC();
    {
        pg8::Gemm g{(const bf16_t*)(ws + WS_MIX), (const bf16_t*)(ws + WS_WOUT), MTOK, DM, DM}; pg8::StaticOrder S; S.init(MTOK, DM, G, bid);
        pg8::EpiRes<true> E{nullptr, (bf16_t*)(ws + WS_XB), (float*)(ws + WS_SS1)};
        pg8::gemm_phase<pg8::EpiRes<true>, true>(lds, g, S, E);
    }
    GRID_SYNC();
    {
        pg8::Gemm g{(const bf16_t*)(ws + WS_XB), (const bf16_t*)(ws + WS_WG), MTOK, NGU, DM}; pg8::StaticOrder S; S.init(MTOK, NGU, G, bid);
        pg8::EpiGU E{(bf16_t*)(ws + WS_ACT), (const float*)(ws + WS_SS1), P.fconv_w, P.fconv_b, (float*)(ws + WS_HALO), (LAS float*)(lds + 131072)};
        pg8::gemm_phase<pg8::EpiGU, true>(lds, g, S, E);
        int kpp = 256; asm volatile("" : "+s"(kpp));
        pg8::Gemm g2{(const bf16_t*)(ws + WS_PB), (const bf16_t*)(ws + WS_WPP), MTOK, DM, kpp}; pg8::StaticOrder S2; S2.init(MTOK, DM, G, bid);
        pg8::EpiStore E2{(bf16_t*)P.out};
        pg8::gemm_phase<pg8::EpiStore, true>(lds, g2, S2, E2);
    }
    GRID_SYNC();
    {
        int tid = threadIdx.x; asm volatile("" : "+v"(tid));
        const float* HALO = (const float*)(ws + WS_HALO); bf16_t* ACT = (bf16_t*)(ws + WS_ACT);
        for (int idx = bid * 512 + tid; idx < (MTOK / 256) * 2 * FF; idx += G * 512) {
            const int col = idx % FF; const int pe_ = idx / FF; const int e = pe_ & 1, pm = pe_ >> 1;
            const float* H = HALO + (size_t)((pm * 2 + e) * 3) * FF;
            float a = H[FF + col]; const float uu = H[2 * FF + col];
            if (e == 0) { if ((pm & 7) != 0) a += HALO[(size_t)(((pm - 1) * 2 + 1) * 3) * FF + col] * P.fconv_w[col]; }
            else        { if ((pm & 7) != 7) a += HALO[(size_t)(((pm + 1) * 2 + 0) * 3) * FF + col] * P.fconv_w[2 * FF + col]; }
            const int row = pm * 256 + (e ? 255 : 0);
            ACT[(size_t)row * FF + col] = (bf16_t)f2bf(gelu1(a) * uu);
        }
    }
    GRID_SYNC();
    {
        pg8::Gemm g{(const bf16_t*)(ws + WS_ACT), (const bf16_t*)(ws + WS_WD), MTOK, DM, FF}; pg8::StaticOrder S; S.init(MTOK, DM, G, bid);
        pg8::EpiRes<true> E{nullptr, (bf16_t*)(ws + WS_XB), (float*)(ws + WS_SS2)};
        pg8::gemm_phase<pg8::EpiRes<true>, true>(lds, g, S, E);
    }
    GRID_SYNC();
    {
        pg8::Gemm g{(const bf16_t*)(ws + WS_XB), (const bf16_t*)(ws + WS_WPG), MTOK, DM, DM}; pg8::StaticOrder S; S.init(MTOK, DM, G, bid);
        pg8::EpiSigPle E{(bf16_t*)(ws + WS_XB), (const bf16_t*)P.out, (const float*)(ws + WS_SS2), P.b_pg, (float*)(ws + WS_SS3)};
        pg8::gemm_phase<pg8::EpiSigPle, true>(lds, g, S, E);
    }
    GRID_SYNC();
    for (int rep = 0; rep < REP_SYNC; ++rep) GRID_SYNC();
    {
        int tid = threadIdx.x; asm volatile("" : "+v"(tid));
        const int lane = tid & 63, wave = tid >> 6;
        const float* ss3 = (const float*)(ws + WS_SS3);
        f32x4 gv[4];
#pragma unroll
        for (int j = 0; j < 4; ++j) gv[j] = *((const f32x4*)P.ln_f_g + lane + 64 * j);
        const int NW = G * 8;
        for (int m0 = bid * 8 + wave; m0 < MTOK; m0 += 2 * NW) {
            const int m1 = (m0 + NW < MTOK) ? m0 + NW : m0;
            u32x2 xv[2][4]; float sv[2];
#pragma unroll
            for (int q = 0; q < 2; ++q) { const int m = q ? m1 : m0; sv[q] = ss3[m]; const u32x2* xr = (const u32x2*)((const bf16_t*)(ws + WS_XB) + (size_t)m * DM) + lane;
#pragma unroll
                for (int j = 0; j < 4; ++j) xv[q][j] = __builtin_nontemporal_load(xr + 64 * j); }
#pragma unroll
            for (int q = 0; q < 2; ++q) { const int m = q ? m1 : m0;
                if (q == 1 && m1 == m0) break;
                const float r = rsqrtf(sv[q] * (1.0f / DM) + EPSF);
                f32x4* orow = (f32x4*)(P.out + (size_t)m * DM) + lane;
#pragma unroll
                for (int j = 0; j < 4; ++j) { const f32x4 v = {bflo(xv[q][j].x), bfhi(xv[q][j].x), bflo(xv[q][j].y), bfhi(xv[q][j].y)}; __builtin_nontemporal_store(v * r * gv[j], orow + 64 * j); } }
        }
    }
}

extern "C" void kernel_launch(void* const* d_in, const int* in_sizes, int n_in, void* d_out, int out_size, void* d_ws, size_t ws_size, hipStream_t stream) {
    static int grid_blocks = 0;
    if (grid_blocks == 0) {
        if (n_in != 24 || ws_size < WS_NEED) { fprintf(stderr, "kernel_launch: unexpected n_in %d / ws %zu\n", n_in, ws_size); grid_blocks = -1; return; }
        int dev = 0, cus = 0, per_cu = 0;
        hipGetDevice(&dev);
        hipDeviceGetAttribute(&cus, hipDeviceAttributeMultiprocessorCount, dev);
        if (hipFuncSetAttribute((const void*)fwd_megakernel, hipFuncAttributeMaxDynamicSharedMemorySize, LDS_BYTES) != hipSuccess) { fprintf(stderr, "hipFuncSetAttribute failed\n"); grid_blocks = -1; return; }
        if (hipOccupancyMaxActiveBlocksPerMultiprocessor(&per_cu, (const void*)fwd_megakernel, 512, LDS_BYTES) != hipSuccess || per_cu < 1) { fprintf(stderr, "occupancy query failed (%d)\n", per_cu); per_cu = 1; }
        (void)hipGetLastError();
        grid_blocks = cus * 1;
        if (grid_blocks <= 0) grid_blocks = 256;
    }
    if (grid_blocks < 0) return;
    Params P{};
    P.x = (const float*)d_in[0]; P.p = (const float*)d_in[1]; P.pos = (const int*)d_in[2];
    P.ln_mix_g = (const float*)d_in[3]; P.w_in = (const float*)d_in[4]; P.mconv_w = (const float*)d_in[5]; P.mconv_b = (const float*)d_in[6];
    P.w_mq = (const float*)d_in[7]; P.w_mk = (const float*)d_in[8]; P.b_ig = (const float*)d_in[9]; P.b_fg = (const float*)d_in[10]; P.gn_g = (const float*)d_in[11];
    P.w_out = (const float*)d_in[12]; P.ln_ffn_g = (const float*)d_in[13]; P.w_fg = (const float*)d_in[14]; P.fconv_w = (const float*)d_in[15]; P.fconv_b = (const float*)d_in[16];
    P.w_fu = (const float*)d_in[17]; P.w_fd = (const float*)d_in[18]; P.ln_ple_g = (const float*)d_in[19]; P.w_pg = (const float*)d_in[20]; P.b_pg = (const float*)d_in[21];
    P.w_pp = (const float*)d_in[22]; P.ln_f_g = (const float*)d_in[23];
    P.out = (float*)d_out; P.ws = (unsigned char*)d_ws;
    for (int j = 0; j < 8; ++j) P.invrev[j] = std::pow(500000.0, -(double)j / 8.0) / 6.283185307179586476925;
    if (hipMemsetAsync((unsigned char*)d_ws + WS_BAR, 0, 16384, stream) != hipSuccess) { fprintf(stderr, "memset failed\n"); return; }
    void* args[] = {&P};
    hipError_t e = hipLaunchCooperativeKernel((const void*)fwd_megakernel, dim3(grid_blocks), dim3(512), args, LDS_BYTES, stream);
    if (e != hipSuccess) fprintf(stderr, "cooperative launch failed: %s (grid %d)\n", hipGetErrorString(e), grid_blocks);
}
```

```cpp
#ifndef REP_ATTN
#define REP_ATTN 1
#endif
#ifndef REP_G
#define REP_G 1
#endif
#ifndef REP_MISC
#define REP_MISC 1
#endif
#ifndef REP_SYNC
#define REP_SYNC 0
#endif
#ifndef REP_SCAN
#define REP_SCAN 1
#endif
#include <hip/hip_runtime.h>
#include <hip/hip_cooperative_groups.h>
#include <cstdio>
#include <cstdint>
#include <cmath>
namespace cg = cooperative_groups;

#define LAS __attribute__((address_space(3)))
typedef unsigned short bf16_t;
typedef short bf16x8 __attribute__((ext_vector_type(8)));
typedef short bf16x4 __attribute__((ext_vector_type(4)));
typedef float f32x4 __attribute__((ext_vector_type(4)));
typedef float f32x2 __attribute__((ext_vector_type(2)));
typedef unsigned u32x4 __attribute__((ext_vector_type(4)));
typedef unsigned u32x2 __attribute__((ext_vector_type(2)));

constexpr int NB = 16, SEQ = 2048, DM = 1024, MTOK = NB * SEQ;
constexpr int ZW = 3072;
constexpr int NZPAD = 3328;
constexpr int NIN = 3088;
constexpr int FF = 2816;
constexpr int NGU = 2 * FF;
constexpr float EPSF = 1e-6f;

constexpr size_t MiB = 1u << 20;
constexpr size_t WS_R0 = 0, WS_SS1 = 128 * 1024, WS_SS2 = 256 * 1024, WS_SS3 = 384 * 1024;
constexpr size_t WS_BAR = 512 * 1024;
constexpr size_t WS_CS = 1 * MiB, WS_GATES = 3 * MiB;
constexpr size_t WS_WIN = 5 * MiB, WS_WOUT = 12 * MiB, WS_WG = 14 * MiB, WS_WU = 20 * MiB, WS_WD = 26 * MiB, WS_WPG = 32 * MiB, WS_WPP = 34 * MiB;
constexpr size_t WS_PB = 36 * MiB;
constexpr size_t WS_XB = 52 * MiB, WS_HF = 52 * MiB, WS_HB = 84 * MiB;
constexpr size_t WS_ZB = 116 * MiB;
constexpr size_t WS_VT1 = 308 * MiB, WS_VT4 = 340 * MiB, WS_VT16 = 372 * MiB;
constexpr size_t WS_MIX = 404 * MiB;
constexpr size_t WS_GP = 116 * MiB, WS_ACT = 292 * MiB, WS_SG = 116 * MiB;
constexpr size_t WS_HALO = 470 * MiB;
constexpr size_t WS_NEED = 480 * MiB;

constexpr int LDS_BYTES = 147456;
constexpr int LDS_ST_OFF = 147392;

struct Params {
    const float* x; const float* p; const int* pos;
    const float* ln_mix_g; const float* w_in; const float* mconv_w; const float* mconv_b; const float* w_mq; const float* w_mk;
    const float* b_ig; const float* b_fg; const float* gn_g; const float* w_out; const float* ln_ffn_g; const float* w_fg; const float* fconv_w; const float* fconv_b;
    const float* w_fu; const float* w_fd; const float* ln_ple_g; const float* w_pg; const float* b_pg; const float* w_pp; const float* ln_f_g;
    float* out; unsigned char* ws;
    double invrev[8];
};

typedef __bf16 bf16x2v __attribute__((ext_vector_type(2)));
__device__ __forceinline__ unsigned f2bf(float f) { return (unsigned)__builtin_bit_cast(unsigned short, (__bf16)f); }
__device__ __forceinline__ unsigned pk2(float lo, float hi) { f32x2 v = {lo, hi}; bf16x2v b = __builtin_convertvector(v, bf16x2v); return __builtin_bit_cast(unsigned, b); }
__device__ __forceinline__ float bflo(unsigned w) { return __builtin_bit_cast(float, w << 16); }
__device__ __forceinline__ float bfhi(unsigned w) { return __builtin_bit_cast(float, w & 0xffff0000u); }
__device__ __forceinline__ float bf1(bf16_t h) { return __builtin_bit_cast(float, ((unsigned)h) << 16); }
__device__ __forceinline__ float wave_sum(float v) {
#pragma unroll
    for (int o = 1; o < 64; o <<= 1) v += __shfl_xor(v, o);
    return v;
}
__device__ __forceinline__ float sigmoidf_(float x) { return 1.0f / (1.0f + __expf(-x)); }
__device__ __forceinline__ float gelu1(float v) {
    const float av = fabsf(v), d = av * 0.2316418882f + 1.0f;
    const float t = __builtin_amdgcn_rcpf(d);
    float q = t * 0.5307027145f + (-0.7265760135f); q = q * t + 0.7107068705f; q = q * t + (-0.142248368f); q = q * t + 0.127414796f; q = q * t;
    const float e = __builtin_amdgcn_exp2f((v * v) * (-0.72134752044f));
    const float m = v * (q * e), r = v - m;
    return v < 0.f ? m : r;
}

namespace pg8 {
constexpr int BM = 256, BK = 64, HALF = 128, HTB = HALF * BK * 2, STAGE_BYTES = 8 * HTB, NXCD = 8, WGM = 8;
__host__ __device__ __forceinline__ int lds_byte(int r, int c) { const int st = (r >> 4) * 2 + (c >> 5), rr = r & 15, cc = c & 31, ob = rr * 64 + cc * 2; return st * 1024 + (ob ^ (((ob >> 9) & 1) << 5)); }
__host__ __device__ __forceinline__ void stage_rc(int b, int& R, int& C) { const int st = b / 1024, sb = b % 1024, swz = sb ^ (((sb >> 9) & 1) << 5); R = (st >> 1) * 16 + swz / 64; C = (st & 1) * 32 + (swz % 64) / 2; }
__host__ __device__ __forceinline__ int perm32(int rho) { const int n = rho >> 4, i = rho & 15; return 8 * (i >> 2) + 4 * n + (i & 3); }

struct Unit { int pm, pn; };
struct Gemm { const bf16_t* A; const bf16_t* Bt; int M, N, K; };

struct StaticOrder {
    int nM, nN, nwg, G, c;
    __device__ void init(int M, int N, int G_, int c_) { nM = M / BM; nN = N / BM; nwg = nM * nN; G = G_; c = c_; }
    __device__ bool next(int i, Unit& u) const {
        const long L = (long)i * G + c; if (L >= nwg) return false;
        int wgid = (int)L; { const int q = nwg / NXCD, r = nwg % NXCD, xcd = wgid % NXCD, off = wgid / NXCD; wgid = (xcd < r ? xcd * (q + 1) : r * (q + 1) + (xcd - r) * q) + off; }
        const int nig = WGM * nN, gid = wgid / nig, fm = gid * WGM, gsz = (nM - fm) < WGM ? (nM - fm) : WGM;
        u.pm = fm + ((wgid % nig) % gsz); u.pn = (wgid % nig) / gsz; return true;
    }
};

template <class Epi, bool ALIGN_EPI>
__device__ __forceinline__ void gemm_phase(LAS unsigned char* lds, const Gemm g, const StaticOrder& S, const Epi& E) {
    int tid = threadIdx.x; asm volatile("" : "+v"(tid));
    const int wid = __builtin_amdgcn_readfirstlane(tid >> 6), lane = tid & 63, wr = wid >> 2, wc = wid & 3, fr = lane & 15, fq = lane >> 4;
    const int K = g.K, nt = K / BK;
    unsigned voffA[2], voffB[2];
#pragma unroll
    for (int i = 0; i < 2; ++i) { int R, C; stage_rc(tid * 16 + i * 8192, R, C); const int Rb = Epi::PERM ? ((R & ~31) + perm32(R & 31)) : R;
        voffA[i] = (unsigned)(R * K + C) * 2u; voffB[i] = (unsigned)(Rb * K + C) * 2u; }
    const size_t kstep = (size_t)(BK * 2);
    const size_t hstep = (size_t)HALF * K * 2;
    const size_t tstep = 2 * hstep;
    const unsigned ldsw = (unsigned)wid * 1024u;
    const int aoff = lds_byte(wr * 64 + fr, fq * 8), boff = lds_byte(wc * 32 + fr, fq * 8);
#define PG8_SA(b, h) (((b) * 2 + (h)) * HTB)
#define PG8_SB(b, h) ((4 + (b) * 2 + (h)) * HTB)
#define PG8_STAGE(bufoff, gbase, voff) do { _Pragma("unroll") for (int _i = 0; _i < 2; ++_i) \
        __builtin_amdgcn_global_load_lds((const unsigned*)((const char*)(gbase) + (voff)[_i]), (LAS unsigned*)(lds + (bufoff) + ldsw + _i * 8192), 16, 0, 0); } while (0)
#define PG8_LDA(dst, b, h) do { _Pragma("unroll") for (int m = 0; m < 4; ++m) _Pragma("unroll") for (int k = 0; k < 2; ++k) dst[m][k] = *(const LAS bf16x8*)(lds + PG8_SA(b, h) + aoff + m * 2048 + k * 1024); } while (0)
#define PG8_LDB(dst, b, h) do { _Pragma("unroll") for (int n = 0; n < 2; ++n) _Pragma("unroll") for (int k = 0; k < 2; ++k) dst[n][k] = *(const LAS bf16x8*)(lds + PG8_SB(b, h) + boff + n * 2048 + k * 1024); } while (0)
#define PG8_MMA(ai, bj, At, Bt) do { __builtin_amdgcn_s_setprio(1); _Pragma("unroll") for (int m = 0; m < 4; ++m) _Pragma("unroll") for (int n = 0; n < 2; ++n) _Pragma("unroll") for (int k = 0; k < 2; ++k) \
        acc[ai][bj][m][n] = __builtin_amdgcn_mfma_f32_16x16x32_bf16(Bt[n][k], At[m][k], acc[ai][bj][m][n], 0, 0, 0); __builtin_amdgcn_s_setprio(0); } while (0)
#define PG8_WAIT_V(n) asm volatile("s_waitcnt vmcnt(" #n ")" ::: "memory")
#define PG8_WAIT_L(n) asm volatile("s_waitcnt lgkmcnt(" #n ")" ::: "memory")
#define PG8_BAR __builtin_amdgcn_s_barrier()
#define PG8_SCHED __builtin_amdgcn_sched_barrier(0)
    Unit cur, nxt; int ui = 0;
    if (!S.next(0, cur)) return;
    f32x4 acc[2][2][4][2];
#pragma unroll
    for (int a = 0; a < 2; ++a)
#pragma unroll
        for (int b = 0; b < 2; ++b)
#pragma unroll
            for (int m = 0; m < 4; ++m)
#pragma unroll
                for (int n = 0; n < 2; ++n) acc[a][b][m][n] = (f32x4){0.f, 0.f, 0.f, 0.f};
    bf16x8 At[4][2], B0[2][2], B1[2][2];
    const char* cA = (const char*)g.A + (size_t)cur.pm * tstep; const char* cB = (const char*)g.Bt + (size_t)cur.pn * tstep;
    PG8_STAGE(PG8_SB(0, 0), cB, voffB); PG8_STAGE(PG8_SB(0, 1), cB + hstep, voffB); PG8_STAGE(PG8_SA(0, 0), cA, voffA); PG8_STAGE(PG8_SA(0, 1), cA + hstep, voffA);
    if (wr == 1) PG8_BAR;
    PG8_WAIT_V(2); PG8_BAR;
    PG8_STAGE(PG8_SB(1, 0), cB + kstep, voffB); PG8_STAGE(PG8_SA(1, 0), cA + kstep, voffA); PG8_STAGE(PG8_SB(1, 1), cB + hstep + kstep, voffB);
    PG8_WAIT_V(6); PG8_BAR;
    for (;;) {
        const bool has_next = S.next(ui + 1, nxt);
        const char* nA = has_next ? (const char*)g.A + (size_t)nxt.pm * tstep : cA; const char* nB = has_next ? (const char*)g.Bt + (size_t)nxt.pn * tstep : cB;
        for (int t = 0; t < nt; t += 2) {
            const bool last = (t == nt - 2);
            const char* a1 = cA + (size_t)(t + 1) * kstep;
            const char* a2 = last ? nA : cA + (size_t)(t + 2) * kstep; const char* b2 = last ? nB : cB + (size_t)(t + 2) * kstep;
            const char* a3 = a2 + kstep; const char* b3 = b2 + kstep;
            PG8_LDB(B0, 0, 0); PG8_LDB(B1, 0, 1); PG8_SCHED; PG8_LDA(At, 0, 0); PG8_STAGE(PG8_SA(1, 1), a1 + hstep, voffA);
            PG8_WAIT_V(8); PG8_WAIT_L(0); PG8_BAR; PG8_MMA(0, 0, At, B0); PG8_MMA(0, 1, At, B1); PG8_BAR; PG8_SCHED;
            PG8_LDA(At, 0, 1); PG8_STAGE(PG8_SB(0, 0), b2, voffB); PG8_STAGE(PG8_SB(0, 1), b2 + hstep, voffB); PG8_STAGE(PG8_SA(0, 0), a2, voffA);
            PG8_WAIT_V(8); PG8_WAIT_L(0); PG8_BAR; PG8_MMA(1, 0, At, B0); PG8_MMA(1, 1, At, B1); PG8_BAR; PG8_SCHED;
            PG8_LDB(B0, 1, 0); PG8_LDB(B1, 1, 1); PG8_SCHED; PG8_LDA(At, 1, 0); PG8_STAGE(PG8_SA(0, 1), a2 + hstep, voffA);
            PG8_WAIT_V(8); PG8_WAIT_L(0); PG8_BAR; PG8_MMA(0, 0, At, B0); PG8_MMA(0, 1, At, B1); PG8_BAR; PG8_SCHED;
            PG8_LDA(At, 1, 1); PG8_STAGE(PG8_SB(1, 0), b3, voffB); PG8_STAGE(PG8_SB(1, 1), b3 + hstep, voffB); PG8_STAGE(PG8_SA(1, 0), a3, voffA);
            PG8_WAIT_V(8); PG8_WAIT_L(0); PG8_BAR; PG8_MMA(1, 0, At, B0); PG8_MMA(1, 1, At, B1); PG8_BAR; PG8_SCHED;
        }
        if constexpr (ALIGN_EPI) { if (wr == 0) PG8_BAR; }
        E(acc, cur, wr, wc, fr, fq);
        if (!has_next) break;
#pragma unroll
        for (int a = 0; a < 2; ++a)
#pragma unroll
            for (int b = 0; b < 2; ++b)
#pragma unroll
                for (int m = 0; m < 4; ++m)
#pragma unroll
                    for (int n = 0; n < 2; ++n) acc[a][b][m][n] = (f32x4){0.f, 0.f, 0.f, 0.f};
        cur = nxt; cA = nA; cB = nB; ++ui;
        if constexpr (ALIGN_EPI) { if (wr == 1) PG8_BAR; }
    }
    PG8_WAIT_V(0);
    if constexpr (!ALIGN_EPI) { if (wr == 0) PG8_BAR; }
    PG8_BAR;
#undef PG8_SA
#undef PG8_SB
#undef PG8_STAGE
#undef PG8_LDA
#undef PG8_LDB
#undef PG8_MMA
#undef PG8_WAIT_V
#undef PG8_WAIT_L
#undef PG8_BAR
#undef PG8_SCHED
}

typedef f32x4 AccT[2][2][4][2];

struct EpiZ {
    static constexpr bool PERM = true;
    bf16_t* ZB; float* gates; const float* r0; const float* cs; bf16_t* VT16;
    __device__ __forceinline__ void operator()(const AccT& acc, const Unit& u, int wr, int wc, int fr, int fq) const {
        const int row0 = u.pm * BM + wr * 64 + fr; const int pn = u.pn;
        if (pn == 12) {
            if (wc == 0 && fq < 2) {
#pragma unroll
                for (int ai = 0; ai < 2; ++ai)
#pragma unroll
                    for (int m = 0; m < 4; ++m) { const int row = row0 + ai * HALF + m * 16; const float r = r0[row];
                        *(f32x4*)(gates + (size_t)row * 16 + 8 * fq) = acc[ai][0][m][0] * r; *(f32x4*)(gates + (size_t)row * 16 + 8 * fq + 4) = acc[ai][0][m][1] * r; }
            }
            return;
        }
        if (pn == 4 || pn == 5) {
            const int bb_ = u.pm >> 3, m16b = 16 * (u.pm & 7) + 4 * wr;
            float rr[2][4];
#pragma unroll
            for (int ai = 0; ai < 2; ++ai)
#pragma unroll
                for (int m = 0; m < 4; ++m) rr[ai][m] = r0[row0 + ai * HALF + m * 16];
#pragma unroll
            for (int bj = 0; bj < 2; ++bj) { const int hh = (pn - 4) * 4 + 2 * bj + (wc >> 1);
                bf16_t* vb = VT16 + ((size_t)((bb_ * 8 + hh) * 64 + 32 * (wc & 1) + 8 * fq)) * SEQ + fr * 128 + m16b;
#pragma unroll
                for (int ai = 0; ai < 2; ++ai)
#pragma unroll
                    for (int n = 0; n < 2; ++n)
#pragma unroll
                        for (int i = 0; i < 4; ++i) { u32x2 w;
                            w.x = pk2(acc[ai][bj][0][n][i] * rr[ai][0], acc[ai][bj][1][n][i] * rr[ai][1]); w.y = pk2(acc[ai][bj][2][n][i] * rr[ai][2], acc[ai][bj][3][n][i] * rr[ai][3]);
                            *(u32x2*)(vb + (size_t)(4 * n + i) * SEQ + 8 * ai) = w; } }
        }
        const bool rot = (pn < 4) && ((wc & 1) == 0);
        const float qs = (pn < 2) ? 0.125f : 1.0f;
        const int col0 = pn * BM + wc * 32 + 8 * fq;
#pragma unroll
        for (int ai = 0; ai < 2; ++ai)
#pragma unroll
            for (int m = 0; m < 4; ++m) { const int row = row0 + ai * HALF + m * 16; const float r = r0[row] * qs;
                f32x4 c0 = {1.f, 1.f, 1.f, 1.f}, c1 = c0, s0 = {0.f, 0.f, 0.f, 0.f}, s1 = s0;
                if (rot) { const float* cp = cs + (size_t)row * 16; c0 = *(const f32x4*)cp; c1 = *(const f32x4*)(cp + 4); s0 = *(const f32x4*)(cp + 8); s1 = *(const f32x4*)(cp + 12);
                    if (fq == 0) { s0 = -s0; s1 = -s1; } else if (fq >= 2) { c0 = (f32x4){1.f, 1.f, 1.f, 1.f}; c1 = c0; s0 = (f32x4){0.f, 0.f, 0.f, 0.f}; s1 = s0; } }
#pragma unroll
                for (int bj = 0; bj < 2; ++bj) { f32x4 v0 = acc[ai][bj][m][0] * r, v1 = acc[ai][bj][m][1] * r;
                    if (rot) { f32x4 p0, p1;
#pragma unroll
                        for (int i = 0; i < 4; ++i) { p0[i] = __shfl_xor(v0[i], 16); p1[i] = __shfl_xor(v1[i], 16); }
                        v0 = v0 * c0 + p0 * s0; v1 = v1 * c1 + p1 * s1; }
                    u32x4 w; w.x = pk2(v0[0], v0[1]); w.y = pk2(v0[2], v0[3]); w.z = pk2(v1[0], v1[1]); w.w = pk2(v1[2], v1[3]);
                    *(u32x4*)(ZB + (size_t)row * ZW + col0 + bj * HALF) = w; } }
    }
};

template <bool BASE_BF16> struct EpiRes {
    static constexpr bool PERM = true;
    const float* basef; bf16_t* xb; float* ss;
    __device__ __forceinline__ void operator()(const AccT& acc, const Unit& u, int wr, int wc, int fr, int fq) const {
        const int row0 = u.pm * BM + wr * 64 + fr; const int col0 = u.pn * BM + wc * 32 + 8 * fq;
#pragma unroll
        for (int ai = 0; ai < 2; ++ai)
#pragma unroll
            for (int m = 0; m < 4; ++m) { const int row = row0 + ai * HALF + m * 16; float sq = 0.f;
#pragma unroll
                for (int bj = 0; bj < 2; ++bj) { const size_t off = (size_t)row * DM + col0 + bj * HALF;
                    f32x4 b0, b1;
                    if (BASE_BF16) { const u32x4 g = *(const u32x4*)(xb + off); b0 = (f32x4){bflo(g.x), bfhi(g.x), bflo(g.y), bfhi(g.y)}; b1 = (f32x4){bflo(g.z), bfhi(g.z), bflo(g.w), bfhi(g.w)}; }
                    else { b0 = *(const f32x4*)(basef + off); b1 = *(const f32x4*)(basef + off + 4); }
                    const f32x4 v0 = b0 + acc[ai][bj][m][0], v1 = b1 + acc[ai][bj][m][1];
                    u32x4 w; w.x = pk2(v0[0], v0[1]); w.y = pk2(v0[2], v0[3]); w.z = pk2(v1[0], v1[1]); w.w = pk2(v1[2], v1[3]);
                    *(u32x4*)(xb + off) = w;
                    sq += (v0[0] * v0[0] + v0[1] * v0[1]) + (v0[2] * v0[2] + v0[3] * v0[3]) + (v1[0] * v1[0] + v1[1] * v1[1]) + (v1[2] * v1[2] + v1[3] * v1[3]); }
                sq += __shfl_xor(sq, 16); sq += __shfl_xor(sq, 32);
                if (fq == 0) atomicAdd(ss + row, sq); }
    }
};

struct EpiGate {
    static constexpr bool PERM = true;
    bf16_t* GP; const float* ss;
    __device__ __forceinline__ void operator()(const AccT& acc, const Unit& u, int wr, int wc, int fr, int fq) const {
        const int row0 = u.pm * BM + wr * 64 + fr; const int col0 = u.pn * BM + wc * 32 + 8 * fq;
#pragma unroll
        for (int ai = 0; ai < 2; ++ai)
#pragma unroll
            for (int m = 0; m < 4; ++m) { const int row = row0 + ai * HALF + m * 16; const float r = rsqrtf(ss[row] * (1.0f / DM) + EPSF);
#pragma unroll
                for (int bj = 0; bj < 2; ++bj) { const f32x4 v0 = acc[ai][bj][m][0] * r, v1 = acc[ai][bj][m][1] * r;
                    u32x4 w; w.x = pk2(v0[0], v0[1]); w.y = pk2(v0[2], v0[3]); w.z = pk2(v1[0], v1[1]); w.w = pk2(v1[2], v1[3]);
                    *(u32x4*)(GP + (size_t)row * FF + col0 + bj * HALF) = w; } }
    }
};

struct EpiUp {
    static constexpr bool PERM = true;
    const bf16_t* GP; bf16_t* ACT; const float* ss; const float* cw; const float* cb;
    __device__ __forceinline__ void operator()(const AccT& acc, const Unit& u, int wr, int wc, int fr, int fq) const {
        const int row0 = u.pm * BM + wr * 64 + fr; const int col0 = u.pn * BM + wc * 32 + 8 * fq;
#pragma unroll
        for (int bj = 0; bj < 2; ++bj) { const int col = col0 + bj * HALF;
            f32x4 w0[2], w1[2], w2[2], bb[2];
#pragma unroll
            for (int n = 0; n < 2; ++n) { w0[n] = *(const f32x4*)(cw + col + 4 * n); w1[n] = *(const f32x4*)(cw + FF + col + 4 * n); w2[n] = *(const f32x4*)(cw + 2 * FF + col + 4 * n); bb[n] = *(const f32x4*)(cb + col + 4 * n); }
#pragma unroll
            for (int ai = 0; ai < 2; ++ai)
#pragma unroll
                for (int m = 0; m < 4; ++m) { const int row = row0 + ai * HALF + m * 16; const int s = row & (SEQ - 1); const float r = rsqrtf(ss[row] * (1.0f / DM) + EPSF);
                    const bf16_t* gp = GP + (size_t)row * FF + col;
                    const u32x4 gc = *(const u32x4*)gp;
                    u32x4 gm = {0u, 0u, 0u, 0u}, gn = {0u, 0u, 0u, 0u};
                    if (s > 0) gm = *(const u32x4*)(gp - FF);
                    if (s < SEQ - 1) gn = *(const u32x4*)(gp + FF);
                    float y[8];
#pragma unroll
                    for (int q = 0; q < 4; ++q) { const int n = q >> 1, i0 = (q & 1) * 2;
                        const float a0 = bflo(gm[q]) * w0[n][i0] + bflo(gc[q]) * w1[n][i0] + bflo(gn[q]) * w2[n][i0] + bb[n][i0];
                        const float a1 = bfhi(gm[q]) * w0[n][i0 + 1] + bfhi(gc[q]) * w1[n][i0 + 1] + bfhi(gn[q]) * w2[n][i0 + 1] + bb[n][i0 + 1];
                        y[2 * q] = gelu1(a0) * (acc[ai][bj][m][n][i0] * r); y[2 * q + 1] = gelu1(a1) * (acc[ai][bj][m][n][i0 + 1] * r); }
                    u32x4 w; w.x = pk2(y[0], y[1]); w.y = pk2(y[2], y[3]); w.z = pk2(y[4], y[5]); w.w = pk2(y[6], y[7]);
                    *(u32x4*)(ACT + (size_t)row * FF + col) = w; } }
    }
};

__device__ __forceinline__ float dpp_ror1(float v) { return __builtin_bit_cast(float, __builtin_amdgcn_update_dpp(0, __builtin_bit_cast(int, v), 0x121, 0xF, 0xF, false)); }
__device__ __forceinline__ float dpp_rol1(float v) { return __builtin_bit_cast(float, __builtin_amdgcn_update_dpp(0, __builtin_bit_cast(int, v), 0x12F, 0xF, 0xF, false)); }
struct EpiGU {
    static constexpr bool PERM = true;
    bf16_t* ACT; const float* ss; const float* cw; const float* cb; float* HALO; LAS float* E;
    __device__ __forceinline__ void operator()(const AccT& acc, const Unit& u, int wr, int wc, int fr, int fq) const {
        const int row0 = u.pm * BM + wr * 64 + fr; const int ecol = wc * 32 + 8 * fq; const int colg = u.pn * 128 + ecol;
        float rr[2][4];
#pragma unroll
        for (int ai = 0; ai < 2; ++ai)
#pragma unroll
            for (int m = 0; m < 4; ++m) rr[ai][m] = rsqrtf(ss[row0 + ai * HALF + m * 16] * (1.0f / DM) + EPSF);
#pragma unroll
        for (int ai = 0; ai < 2; ++ai) { const int k = 2 * ai + wr;
            if (fr == 0) { *(LAS f32x4*)(E + (k * 2 + 0) * 128 + ecol) = acc[ai][0][0][0] * rr[ai][0]; *(LAS f32x4*)(E + (k * 2 + 0) * 128 + ecol + 4) = acc[ai][0][0][1] * rr[ai][0]; }
            if (fr == 15) { *(LAS f32x4*)(E + (k * 2 + 1) * 128 + ecol) = acc[ai][0][3][0] * rr[ai][3]; *(LAS f32x4*)(E + (k * 2 + 1) * 128 + ecol + 4) = acc[ai][0][3][1] * rr[ai][3]; } }
        asm volatile("s_waitcnt lgkmcnt(0)" ::: "memory"); __builtin_amdgcn_s_barrier(); asm volatile("" ::: "memory");
        f32x4 w0[2], w1[2], w2[2], bb[2];
#pragma unroll
        for (int n = 0; n < 2; ++n) { w0[n] = *(const f32x4*)(cw + colg + 4 * n); w1[n] = *(const f32x4*)(cw + FF + colg + 4 * n); w2[n] = *(const f32x4*)(cw + 2 * FF + colg + 4 * n); bb[n] = *(const f32x4*)(cb + colg + 4 * n); }
#pragma unroll
        for (int ai = 0; ai < 2; ++ai) { const int k = 2 * ai + wr;
            f32x4 pe[2], ne[2];
#pragma unroll
            for (int n = 0; n < 2; ++n) { pe[n] = (f32x4){0.f, 0.f, 0.f, 0.f}; ne[n] = pe[n];
                if (k > 0) pe[n] = *(const LAS f32x4*)(E + ((k - 1) * 2 + 1) * 128 + ecol + 4 * n);
                if (k < 3) ne[n] = *(const LAS f32x4*)(E + ((k + 1) * 2 + 0) * 128 + ecol + 4 * n); }
            f32x4 g[4][2];
#pragma unroll
            for (int m = 0; m < 4; ++m)
#pragma unroll
                for (int n = 0; n < 2; ++n) g[m][n] = acc[ai][0][m][n] * rr[ai][m];
            f32x4 rorPrev[2] = {pe[0], pe[1]}, rolCur[2];
#pragma unroll
            for (int n = 0; n < 2; ++n)
#pragma unroll
                for (int i = 0; i < 4; ++i) rolCur[n][i] = dpp_rol1(g[0][n][i]);
#pragma unroll
            for (int m = 0; m < 4; ++m) { const int row = row0 + ai * HALF + m * 16;
                f32x4 pv[2], nv[2], rolNext[2];
#pragma unroll
                for (int n = 0; n < 2; ++n)
#pragma unroll
                    for (int i = 0; i < 4; ++i) { const float rc = dpp_ror1(g[m][n][i]); pv[n][i] = fr > 0 ? rc : rorPrev[n][i]; rorPrev[n][i] = rc;
                        rolNext[n][i] = (m < 3) ? dpp_rol1(g[m < 3 ? m + 1 : 3][n][i]) : ne[n][i]; nv[n][i] = fr < 15 ? rolCur[n][i] : rolNext[n][i]; rolCur[n][i] = rolNext[n][i]; }
                const bool top = (k == 0 && m == 0 && fr == 0), bot = (k == 3 && m == 3 && fr == 15);
                float y[8];
#pragma unroll
                for (int n = 0; n < 2; ++n) { const f32x4 uu = acc[ai][1][m][n] * rr[ai][m];
                    const f32x4 amid = g[m][n] * w1[n] + bb[n]; const f32x4 a = pv[n] * w0[n] + (amid + nv[n] * w2[n]);
#pragma unroll
                    for (int i = 0; i < 4; ++i) y[4 * n + i] = gelu1(a[i]) * uu[i];
                    if (top) { float* H = HALO + (size_t)((u.pm * 2 + 0) * 3) * FF + colg + 4 * n; *(f32x4*)H = g[m][n]; *(f32x4*)(H + FF) = amid + nv[n] * w2[n]; *(f32x4*)(H + 2 * FF) = uu; }
                    if (bot) { float* H = HALO + (size_t)((u.pm * 2 + 1) * 3) * FF + colg + 4 * n; *(f32x4*)H = g[m][n]; *(f32x4*)(H + FF) = pv[n] * w0[n] + amid; *(f32x4*)(H + 2 * FF) = uu; } }
                u32x4 w; w.x = pk2(y[0], y[1]); w.y = pk2(y[2], y[3]); w.z = pk2(y[4], y[5]); w.w = pk2(y[6], y[7]);
                *(u32x4*)(ACT + (size_t)row * FF + colg) = w; }
        }
    }
};

struct EpiStore {
    static constexpr bool PERM = true;
    bf16_t* O;
    __device__ __forceinline__ void operator()(const AccT& acc, const Unit& u, int wr, int wc, int fr, int fq) const {
        const int row0 = u.pm * BM + wr * 64 + fr; const int col0 = u.pn * BM + wc * 32 + 8 * fq;
#pragma unroll
        for (int ai = 0; ai < 2; ++ai)
#pragma unroll
            for (int m = 0; m < 4; ++m) { const int row = row0 + ai * HALF + m * 16;
#pragma unroll
                for (int bj = 0; bj < 2; ++bj) { const f32x4 v0 = acc[ai][bj][m][0], v1 = acc[ai][bj][m][1];
                    u32x4 w; w.x = pk2(v0[0], v0[1]); w.y = pk2(v0[2], v0[3]); w.z = pk2(v1[0], v1[1]); w.w = pk2(v1[2], v1[3]);
                    *(u32x4*)(O + (size_t)row * DM + col0 + bj * HALF) = w; } }
    }
};

struct EpiSigPle {
    static constexpr bool PERM = true;
    bf16_t* xb; const bf16_t* PP; const float* ssin; const float* bias; float* ss;
    __device__ __forceinline__ void operator()(const AccT& acc, const Unit& u, int wr, int wc, int fr, int fq) const {
        const int row0 = u.pm * BM + wr * 64 + fr; const int col0 = u.pn * BM + wc * 32 + 8 * fq;
#pragma unroll
        for (int ai = 0; ai < 2; ++ai)
#pragma unroll
            for (int m = 0; m < 4; ++m) { const int row = row0 + ai * HALF + m * 16; const float r = rsqrtf(ssin[row] * (1.0f / DM) + EPSF); float sq = 0.f;
#pragma unroll
                for (int bj = 0; bj < 2; ++bj) { const size_t off = (size_t)row * DM + col0 + bj * HALF;
                    const u32x4 xbv = *(const u32x4*)(xb + off); const u32x4 pv = *(const u32x4*)(PP + off);
                    const f32x4 x0 = {bflo(xbv.x), bfhi(xbv.x), bflo(xbv.y), bfhi(xbv.y)}, x1 = {bflo(xbv.z), bfhi(xbv.z), bflo(xbv.w), bfhi(xbv.w)};
                    const f32x4 p0 = {bflo(pv.x), bfhi(pv.x), bflo(pv.y), bfhi(pv.y)}, p1 = {bflo(pv.z), bfhi(pv.z), bflo(pv.w), bfhi(pv.w)};
                    const f32x4 a0 = acc[ai][bj][m][0] * r + *(const f32x4*)(bias + col0 + bj * HALF), a1 = acc[ai][bj][m][1] * r + *(const f32x4*)(bias + col0 + bj * HALF + 4);
                    const f32x4 s0 = {sigmoidf_(a0[0]), sigmoidf_(a0[1]), sigmoidf_(a0[2]), sigmoidf_(a0[3])}, s1 = {sigmoidf_(a1[0]), sigmoidf_(a1[1]), sigmoidf_(a1[2]), sigmoidf_(a1[3])};
                    const f32x4 v0 = x0 + p0 * s0, v1 = x1 + p1 * s1;
                    u32x4 w; w.x = pk2(v0[0], v0[1]); w.y = pk2(v0[2], v0[3]); w.z = pk2(v1[0], v1[1]); w.w = pk2(v1[2], v1[3]);
                    *(u32x4*)(xb + off) = w;
                    sq += (v0[0] * v0[0] + v0[1] * v0[1]) + (v0[2] * v0[2] + v0[3] * v0[3]) + (v1[0] * v1[0] + v1[1] * v1[1]) + (v1[2] * v1[2] + v1[3] * v1[3]); }
                sq += __shfl_xor(sq, 16); sq += __shfl_xor(sq, 32);
                if (fq == 0) atomicAdd(ss + row, sq);
                asm volatile("" ::: "memory"); }
    }
};
}

__device__ __forceinline__ void transpose_item(const float* W, int K, int N, int nblk, const float* gk, bf16_t* WT, LAS float* scr, int item, int lane, int rowmode = 0) {
    const int kb = item / nblk, nb = item % nblk, k0 = 64 * kb, n0 = 32 * nb;
    const int d0 = rowmode == 0 ? n0 : (256 * (n0 >> 7) + (n0 & 127) + (rowmode == 2 ? 128 : 0));
    const int n = n0 + (lane & 31);
#pragma unroll 8
    for (int i = 0; i < 32; ++i) { const int kk = 2 * i + (lane >> 5); float v = 0.f; if (n < N) v = __builtin_nontemporal_load(&W[(size_t)(k0 + kk) * N + n]); if (gk) v *= gk[k0 + kk]; scr[kk * 33 + (lane & 31)] = v; }
    asm volatile("s_waitcnt lgkmcnt(0)" ::: "memory");
    const int c = lane & 7;
#pragma unroll
    for (int j = 0; j < 4; ++j) { const int nn = (lane >> 3) + 8 * j; const LAS float* s = scr + (8 * c) * 33 + nn;
        u32x4 o; o.x = pk2(s[0 * 33], s[1 * 33]); o.y = pk2(s[2 * 33], s[3 * 33]); o.z = pk2(s[4 * 33], s[5 * 33]); o.w = pk2(s[6 * 33], s[7 * 33]);
        *(u32x4*)(WT + (size_t)(d0 + nn) * K + k0 + 8 * c) = o; }
    asm volatile("s_waitcnt lgkmcnt(0)" ::: "memory");
}

__device__ __forceinline__ void phase_prologue(const Params& P, LAS unsigned char* lds, int G) {
    int tid = threadIdx.x; asm volatile("" : "+v"(tid));
    const int lane = tid & 63, wave = tid >> 6;
    const int gw = blockIdx.x * 8 + wave, NGW = G * 8;
    unsigned char* ws = P.ws;
    LAS float* scr = (LAS float*)(lds + wave * 16384);
    constexpr int I_IN = 16 * (NZPAD / 32), I_OUT = 16 * 32, I_G = 16 * (FF / 32), I_D = (FF / 64) * 32, I_PP = 4 * 32;
    constexpr int NITEMS = I_IN + I_OUT + 2 * I_G + I_D + I_OUT + I_PP;
    for (int it = gw; it < NITEMS; it += NGW) {
        int r = it;
        if (r < I_IN) { transpose_item(P.w_in, DM, NIN, NZPAD / 32, P.ln_mix_g, (bf16_t*)(ws + WS_WIN), scr, r, lane); continue; } r -= I_IN;
        if (r < I_OUT) { transpose_item(P.w_out, DM, DM, 32, nullptr, (bf16_t*)(ws + WS_WOUT), scr, r, lane); continue; } r -= I_OUT;
        if (r < I_G) { transpose_item(P.w_fg, DM, FF, FF / 32, P.ln_ffn_g, (bf16_t*)(ws + WS_WG), scr, r, lane, 1); continue; } r -= I_G;
        if (r < I_G) { transpose_item(P.w_fu, DM, FF, FF / 32, P.ln_ffn_g, (bf16_t*)(ws + WS_WG), scr, r, lane, 2); continue; } r -= I_G;
        if (r < I_D) { transpose_item(P.w_fd, FF, DM, 32, nullptr, (bf16_t*)(ws + WS_WD), scr, r, lane); continue; } r -= I_D;
        if (r < I_OUT) { transpose_item(P.w_pg, DM, DM, 32, P.ln_ple_g, (bf16_t*)(ws + WS_WPG), scr, r, lane); continue; } r -= I_OUT;
        transpose_item(P.w_pp, 256, DM, 32, nullptr, (bf16_t*)(ws + WS_WPP), scr, r, lane);
    }
    float* r0 = (float*)(ws + WS_R0); float* cs = (float*)(ws + WS_CS);
    bf16_t* XB = (bf16_t*)(ws + WS_XB); bf16_t* PB = (bf16_t*)(ws + WS_PB);
    for (int m0 = gw; m0 < MTOK; m0 += 2 * NGW) {
        const int m1 = (m0 + NGW < MTOK) ? m0 + NGW : m0;
        f32x4 v[2][4]; f32x4 pv[2]; int ps[2];
#pragma unroll
        for (int q = 0; q < 2; ++q) { const int m = q ? m1 : m0; const f32x4* xr = (const f32x4*)(P.x + (size_t)m * DM) + lane;
#pragma unroll
            for (int j = 0; j < 4; ++j) v[q][j] = __builtin_nontemporal_load(xr + 64 * j);
            pv[q] = __builtin_nontemporal_load((const f32x4*)(P.p + (size_t)m * 256) + lane); ps[q] = P.pos[m]; }
#pragma unroll
        for (int q = 0; q < 2; ++q) { const int m = q ? m1 : m0;
            if (q == 1 && m1 == m0) break;
            float s = 0.f;
#pragma unroll
            for (int j = 0; j < 4; ++j) s += (v[q][j].x * v[q][j].x + v[q][j].y * v[q][j].y) + (v[q][j].z * v[q][j].z + v[q][j].w * v[q][j].w);
            s = wave_sum(s);
            u32x2* o8 = (u32x2*)(XB + (size_t)m * DM) + lane;
#pragma unroll
            for (int j = 0; j < 4; ++j) { u32x2 w; w.x = pk2(v[q][j].x, v[q][j].y); w.y = pk2(v[q][j].z, v[q][j].w); o8[64 * j] = w; }
            if (lane == 0) r0[m] = rsqrtf(s * (1.0f / DM) + EPSF);
            u32x2 pw; pw.x = pk2(pv[q].x, pv[q].y); pw.y = pk2(pv[q].z, pv[q].w);
            *((u32x2*)(PB + (size_t)m * 256) + lane) = pw;
            if (lane < 8) {
                const double rev = (double)ps[q] * P.invrev[lane];
                const float fr = (float)(rev - floor(rev));
                cs[(size_t)m * 16 + lane] = __builtin_amdgcn_cosf(fr);
                cs[(size_t)m * 16 + 8 + lane] = __builtin_amdgcn_sinf(fr);
            } }
    }
    float* ssz = (float*)(ws + WS_SS1);
    for (int i = blockIdx.x * 512 + tid; i < 3 * MTOK; i += G * 512) ssz[i] = 0.f;
}

__device__ __forceinline__ void vtrans_unit(const Params& P, LAS unsigned char* lds, int unit) {
    int tid = threadIdx.x; asm volatile("" : "+v"(tid));
    const int blk = unit & 7, h = (unit >> 3) & 7, b = unit >> 6;
    const int s0 = blk * 256;
    unsigned char* ws = P.ws;
    const bf16_t* ZB = (const bf16_t*)(ws + WS_ZB);
    LAS bf16_t* tile = (LAS bf16_t*)lds;
    __syncthreads();
#pragma unroll
    for (int i = 0; i < 4; ++i) { const int ch = tid + 512 * i; const int t = ch >> 3, dc = ch & 7;
        const u32x4 v = *(const u32x4*)(ZB + (size_t)(b * SEQ + s0 + t) * ZW + 1024 + h * 64 + dc * 8);
        LAS unsigned* dst = (LAS unsigned*)(tile + t * 66 + dc * 8);
        dst[0] = v.x; dst[1] = v.y; dst[2] = v.z; dst[3] = v.w; }
    __syncthreads();
    const size_t hb = (size_t)((b * 8 + h) * 64) * SEQ;
    bf16_t* V1 = (bf16_t*)(ws + WS_VT1) + hb; bf16_t* V4 = (bf16_t*)(ws + WS_VT4) + hb; bf16_t* V16 = (bf16_t*)(ws + WS_VT16) + hb;
#pragma unroll
    for (int i = 0; i < 4; ++i) { const int ch = tid + 512 * i; const int d = ch >> 5, t8 = ch & 31;
        unsigned short e[8];
#pragma unroll
        for (int k = 0; k < 8; ++k) e[k] = tile[(t8 * 8 + k) * 66 + d];
        u32x4 w; w.x = e[0] | ((unsigned)e[1] << 16); w.y = e[2] | ((unsigned)e[3] << 16); w.z = e[4] | ((unsigned)e[5] << 16); w.w = e[6] | ((unsigned)e[7] << 16);
        *(u32x4*)(V1 + (size_t)d * SEQ + s0 + t8 * 8) = w; }
#pragma unroll
    for (int i = 0; i < 4; ++i) { const int ch = tid + 512 * i; const int d = ch >> 5, r = (ch >> 3) & 3, m8 = ch & 7;
        unsigned short e[8];
#pragma unroll
        for (int k = 0; k < 8; ++k) e[k] = tile[(4 * (m8 * 8 + k) + r) * 66 + d];
        u32x4 w; w.x = e[0] | ((unsigned)e[1] << 16); w.y = e[2] | ((unsigned)e[3] << 16); w.z = e[4] | ((unsigned)e[5] << 16); w.w = e[6] | ((unsigned)e[7] << 16);
        *(u32x4*)(V4 + (size_t)d * SEQ + r * 512 + (s0 >> 2) + m8 * 8) = w; }
#pragma unroll
    for (int i = 0; i < 4; ++i) { const int ch = tid + 512 * i; const int d = ch >> 5, r = (ch >> 1) & 15, m8 = ch & 1;
        unsigned short e[8];
#pragma unroll
        for (int k = 0; k < 8; ++k) e[k] = tile[(16 * (m8 * 8 + k) + r) * 66 + d];
        u32x4 w; w.x = e[0] | ((unsigned)e[1] << 16); w.y = e[2] | ((unsigned)e[3] << 16); w.z = e[4] | ((unsigned)e[5] << 16); w.w = e[6] | ((unsigned)e[7] << 16);
        *(u32x4*)(V16 + (size_t)d * SEQ + r * 128 + (s0 >> 4) + m8 * 8) = w; }
}

constexpr int SC_UC = 0, SC_P = 0  , SC_Q = 17408, SC_K = 34816, SC_KW = 52224, SC_VT = 70656, SC_CB = 91392, SC_F = 130560;
constexpr int NE = 144, NCT = 9;
__device__ __forceinline__ void scan_item(const Params& P, LAS unsigned char* lds, int item) {
    int tid = threadIdx.x; asm volatile("" : "+v"(tid));
    const int lane = tid & 63, w = __builtin_amdgcn_readfirstlane(tid >> 6), qi = lane & 15, quad = lane >> 4;
    const int dir = item & 1, h = (item >> 1) & 3, b = item >> 3;
    unsigned char* ws = P.ws;
    const bf16_t* ZB = (const bf16_t*)(ws + WS_ZB);
    const float* gates = (const float*)(ws + WS_GATES);
    bf16_t* HB = (bf16_t*)P.out + (dir ? (size_t)MTOK * 512 : 0);
    LAS bf16_t* ucS = (LAS bf16_t*)(lds + SC_UC); LAS bf16_t* qS = (LAS bf16_t*)(lds + SC_Q); LAS bf16_t* kS = (LAS bf16_t*)(lds + SC_K);
    LAS bf16_t* kwT = (LAS bf16_t*)(lds + SC_KW); LAS bf16_t* vT = (LAS bf16_t*)(lds + SC_VT); LAS bf16_t* pS = (LAS bf16_t*)(lds + SC_P); LAS bf16_t* CbT = (LAS bf16_t*)(lds + SC_CB);
    LAS float* cS = (LAS float*)(lds + SC_F); LAS float* MS = cS + 64; LAS float* aS = cS + 128; LAS float* eS = cS + 192; LAS float* wS = cS + 256; LAS float* denS = cS + 320; LAS float* misc = cS + 384;
    __syncthreads();
    bf16x8 wqf[4], wkf[4];
    {
        const float* wq = P.w_mq + (size_t)h * 128 * 128 + 16 * w + qi; const float* wk = P.w_mk + (size_t)h * 128 * 128 + 16 * w + qi;
        const float ksc = 0.08838834764831845f;
#pragma unroll
        for (int ks = 0; ks < 4; ++ks)
#pragma unroll
            for (int i = 0; i < 8; ++i) { const int d = ks * 32 + quad * 8 + i; wqf[ks][i] = (short)f2bf(wq[(size_t)d * 128]); wkf[ks][i] = (short)f2bf(wk[(size_t)d * 128] * ksc); }
    }
    for (int i = tid; i < NE * 136 / 2; i += 512) ((LAS unsigned*)CbT)[i] = 0u;
    for (int i = tid; i < 16 * 72; i += 512) vT[128 * 72 + i] = (i < 72) ? (bf16_t)0x3F80 : (bf16_t)0;
    f32x4 C[NCT];
#pragma unroll
    for (int ct = 0; ct < NCT; ++ct) C[ct] = (f32x4){0.f, 0.f, 0.f, 0.f};
    float m_run = 0.f;
    const float big = P.b_ig[dir * 4 + h], bfg = P.b_fg[dir * 4 + h];
    __syncthreads();
    u32x4 uc0, uc1, um0, um1, un0, un1, vvA, vvB; float pig = 0.f, pfg = 0.f;
#define SCAN_PREFETCH(cidx) do { const int cc_ = dir ? 31 - (cidx) : (cidx); const int t0_ = cc_ * 64; \
        { const int s_ = tid >> 3, dc_ = tid & 7; const int pos_ = dir ? t0_ + 63 - s_ : t0_ + s_; const size_t tok_ = (size_t)b * SEQ + pos_; \
          const bf16_t* up_ = ZB + tok_ * ZW + 1536 + h * 128 + dc_ * 16; \
          uc0 = *(const u32x4*)up_; uc1 = *(const u32x4*)(up_ + 8); \
          um0 = (u32x4){0u, 0u, 0u, 0u}; um1 = um0; un0 = um0; un1 = um0; \
          if (pos_ > 0) { um0 = *(const u32x4*)(up_ - ZW); um1 = *(const u32x4*)(up_ - ZW + 8); } \
          if (pos_ < SEQ - 1) { un0 = *(const u32x4*)(up_ + ZW); un1 = *(const u32x4*)(up_ + ZW + 8); } \
          vvA = *(const u32x4*)(ZB + tok_ * ZW + 2048 + h * 128 + dc_ * 16); vvB = *(const u32x4*)(ZB + tok_ * ZW + 2048 + h * 128 + dc_ * 16 + 8); } \
        if (w == 0) { const int pos_ = dir ? t0_ + 63 - lane : t0_ + lane; const size_t tok_ = (size_t)b * SEQ + pos_; \
          pig = gates[tok_ * 16 + dir * 4 + h]; pfg = gates[tok_ * 16 + 8 + dir * 4 + h]; } } while (0)
    SCAN_PREFETCH(0);
    for (int c = 0; c < 32; ++c) {
        const int cc = dir ? 31 - c : c; const int t0 = cc * 64;
        if (w == 0) {
            const float ig = pig + big; const float fg = pfg + bfg;
            const float lf = fminf(fg, 0.f) - log1pf(__expf(-fabsf(fg)));
            float bs = lf;
#pragma unroll
            for (int o = 1; o < 64; o <<= 1) { const float t = __shfl_up(bs, o); if (lane >= o) bs += t; }
            const float cv = ig - bs; float pm = cv;
#pragma unroll
            for (int o = 1; o < 64; o <<= 1) { const float t = __shfl_up(pm, o); if (lane >= o) pm = fmaxf(pm, t); }
            const float Mt = fmaxf(m_run, pm);
            const float M63 = __shfl(Mt, 63), g = __shfl(bs, 63);
            cS[lane] = cv; MS[lane] = Mt; aS[lane] = __expf(m_run - Mt); eS[lane] = __expf(-(bs + Mt)); wS[lane] = __expf(cv - M63);
            if (lane == 0) misc[0] = __expf(m_run - M63);
            m_run = g + M63;
        }
        {
            const int s = tid >> 3, dc = tid & 7; const int pos = dir ? t0 + 63 - s : t0 + s; const size_t tok = (size_t)b * SEQ + pos;
            const int ch = h * 128 + dc * 16;
            unsigned ow[8];
#pragma unroll
            for (int q = 0; q < 8; ++q) { const unsigned m_ = q < 4 ? um0[q & 3] : um1[q & 3], c_ = q < 4 ? uc0[q & 3] : uc1[q & 3], n_ = q < 4 ? un0[q & 3] : un1[q & 3];
                const int cch = ch + 2 * q;
                const float a0 = bflo(m_) * P.mconv_w[cch] + bflo(c_) * P.mconv_w[512 + cch] + bflo(n_) * P.mconv_w[1024 + cch] + P.mconv_b[cch];
                const float a1 = bfhi(m_) * P.mconv_w[cch + 1] + bfhi(c_) * P.mconv_w[512 + cch + 1] + bfhi(n_) * P.mconv_w[1024 + cch + 1] + P.mconv_b[cch + 1];
                ow[q] = pk2(a0 * sigmoidf_(a0), a1 * sigmoidf_(a1)); }
            LAS u32x4* dst = (LAS u32x4*)(ucS + s * 136 + dc * 16);
            dst[0] = (u32x4){ow[0], ow[1], ow[2], ow[3]}; dst[1] = (u32x4){ow[4], ow[5], ow[6], ow[7]};
            const int e0 = dc * 16;
            const int sc_ = (s + 8 * dc) & 63;
#pragma unroll
            for (int q = 0; q < 4; ++q) { const unsigned wa = vvA[q], wb = vvB[q];
                vT[(e0 + 2 * q) * 72 + sc_] = (bf16_t)(wa & 0xffff); vT[(e0 + 2 * q + 1) * 72 + sc_] = (bf16_t)(wa >> 16);
                vT[(e0 + 8 + 2 * q) * 72 + sc_] = (bf16_t)(wb & 0xffff); vT[(e0 + 8 + 2 * q + 1) * 72 + sc_] = (bf16_t)(wb >> 16); }
        }
        __syncthreads();
        { const int cn = c < 31 ? c + 1 : 31; SCAN_PREFETCH(cn); }
#pragma unroll
        for (int st = 0; st < 4; ++st) {
            f32x4 aq = {0.f, 0.f, 0.f, 0.f}, ak = aq;
            const int s = st * 16 + qi;
#pragma unroll
            for (int ks = 0; ks < 4; ++ks) { const bf16x8 uf = *(const LAS bf16x8*)(ucS + s * 136 + ks * 32 + quad * 8);
                aq = __builtin_amdgcn_mfma_f32_16x16x32_bf16(wqf[ks], uf, aq, 0, 0, 0); ak = __builtin_amdgcn_mfma_f32_16x16x32_bf16(wkf[ks], uf, ak, 0, 0, 0); }
            const int e = 16 * w + quad * 4;
            u32x2 qw; qw.x = pk2(aq[0], aq[1]); qw.y = pk2(aq[2], aq[3]); *(LAS u32x2*)(qS + s * 136 + e) = qw;
            u32x2 kw; kw.x = pk2(ak[0], ak[1]); kw.y = pk2(ak[2], ak[3]); *(LAS u32x2*)(kS + s * 136 + e) = kw;
            const float wsv = wS[s];
#pragma unroll
            for (int j = 0; j < 4; ++j) kwT[(e + j) * 72 + s] = (bf16_t)f2bf(ak[j] * wsv);
        }
        __syncthreads();
        {
            const int tt = w >> 1; const int t = tt * 16 + qi; const float Mt = MS[t];
#pragma unroll
            for (int si = 0; si < 2; ++si) { const int st = (w & 1) * 2 + si; const int srow = st * 16 + qi;
                f32x4 sa = {0.f, 0.f, 0.f, 0.f};
#pragma unroll
                for (int ks = 0; ks < 4; ++ks) { const bf16x8 kf = *(const LAS bf16x8*)(kS + srow * 136 + ks * 32 + quad * 8); const bf16x8 qf = *(const LAS bf16x8*)(qS + t * 136 + ks * 32 + quad * 8);
                    sa = __builtin_amdgcn_mfma_f32_16x16x32_bf16(kf, qf, sa, 0, 0, 0); }
                float pv[4];
#pragma unroll
                for (int j = 0; j < 4; ++j) { const int s = st * 16 + quad * 4 + j; pv[j] = (s <= t) ? sa[j] * __expf(cS[s] - Mt) : 0.f; }
                u32x2 pw; pw.x = pk2(pv[0], pv[1]); pw.y = pk2(pv[2], pv[3]); *(LAS u32x2*)(pS + t * 72 + st * 16 + quad * 4) = pw; }
        }
        __syncthreads();
        {
            const int tt = w >> 1; const int t = tt * 16 + qi; const float at = aS[t];
            const int ct0 = (w & 1) ? 5 : 0; const int nct = (w & 1) ? 4 : 5;
            f32x4 na[5];
#pragma unroll
            for (int ci = 0; ci < 5; ++ci) { na[ci] = (f32x4){0.f, 0.f, 0.f, 0.f};
                if (ci < nct) { const int ep = (ct0 + ci) * 16 + qi;
#pragma unroll
                    for (int ks = 0; ks < 4; ++ks) { const bf16x8 cf = *(const LAS bf16x8*)(CbT + ep * 136 + ks * 32 + quad * 8); const bf16x8 qf = *(const LAS bf16x8*)(qS + t * 136 + ks * 32 + quad * 8);
                        na[ci] = __builtin_amdgcn_mfma_f32_16x16x32_bf16(cf, qf, na[ci], 0, 0, 0); }
                    na[ci] = na[ci] * at;
#pragma unroll
                    for (int ks = 0; ks < 2; ++ks) { const bf16x8 vf = *(const LAS bf16x8*)(vT + ep * 72 + ((ks * 32 + quad * 8 + 8 * (ep >> 4)) & 63)); const bf16x8 pf = *(const LAS bf16x8*)(pS + t * 72 + ks * 32 + quad * 8);
                        na[ci] = __builtin_amdgcn_mfma_f32_16x16x32_bf16(vf, pf, na[ci], 0, 0, 0); } } }
            if ((w & 1) && quad == 0) denS[t] = na[3][0];
            __syncthreads();
            const float den = denS[t]; const float dn = fmaxf(fabsf(den), eS[t]); const float inv = 1.0f / dn;
            const int pos = dir ? t0 + 63 - t : t0 + t; const size_t tok = (size_t)b * SEQ + pos;
#pragma unroll
            for (int ci = 0; ci < 5; ++ci) { const int ct = ct0 + ci;
                if (ci < nct && ct < 8) { u32x2 hw; hw.x = pk2(na[ci][0] * inv, na[ci][1] * inv); hw.y = pk2(na[ci][2] * inv, na[ci][3] * inv);
                    *(u32x2*)(HB + tok * 512 + h * 128 + ct * 16 + quad * 4) = hw; } }
        }
        {
            const float decay = misc[0];
            const int drow = 16 * w + qi;
            bf16x8 kf[2];
#pragma unroll
            for (int ks = 0; ks < 2; ++ks) kf[ks] = *(const LAS bf16x8*)(kwT + drow * 72 + ks * 32 + quad * 8);
#pragma unroll
            for (int ct = 0; ct < NCT; ++ct) { C[ct] = C[ct] * decay;
#pragma unroll
                for (int ks = 0; ks < 2; ++ks) { const bf16x8 vf = *(const LAS bf16x8*)(vT + (ct * 16 + qi) * 72 + ((ks * 32 + quad * 8 + 8 * ct) & 63));
                    C[ct] = __builtin_amdgcn_mfma_f32_16x16x32_bf16(kf[ks], vf, C[ct], 0, 0, 0); }
                u32x2 cw; cw.x = pk2(C[ct][0], C[ct][1]); cw.y = pk2(C[ct][2], C[ct][3]);
                *(LAS u32x2*)(CbT + (ct * 16 + qi) * 136 + 16 * w + quad * 4) = cw; }
        }
        __syncthreads();
    }
}

__device__ __forceinline__ int iclamp(int v, int lo, int hi) { return v < lo ? lo : (v > hi ? hi : v); }
__device__ __forceinline__ void attn_step(const bf16x8 (&kf)[2][2], const bf16x8 (&vf)[4], const bf16x8 (&qf)[2], f32x4 (&o)[4], float& mrun, float& lrun,
                                          int k0, int M, int mq, int quad) {
    f32x4 sa[2];
#pragma unroll
    for (int T = 0; T < 2; ++T) { sa[T] = (f32x4){0.f, 0.f, 0.f, 0.f};
        sa[T] = __builtin_amdgcn_mfma_f32_16x16x32_bf16(kf[T][0], qf[0], sa[T], 0, 0, 0);
        sa[T] = __builtin_amdgcn_mfma_f32_16x16x32_bf16(kf[T][1], qf[1], sa[T], 0, 0, 0); }
    float sc[8]; float mx = -1e30f;
#pragma unroll
    for (int T = 0; T < 2; ++T)
#pragma unroll
        for (int jj = 0; jj < 4; ++jj) { const int kk = k0 + 8 * quad + 4 * T + jj; const int dq = kk - mq;
            const bool valid = (kk >= 0) && (kk < M) && (dq >= -64) && (dq <= 64);
            const float sv = valid ? sa[T][jj] : -1e30f; sc[T * 4 + jj] = sv; mx = fmaxf(mx, sv); }
    mx = fmaxf(mx, __shfl_xor(mx, 16)); mx = fmaxf(mx, __shfl_xor(mx, 32));
    const float mnew = fmaxf(mrun, mx); const float scale = __expf(mrun - mnew); mrun = mnew;
    float ps[8]; float lsum = 0.f;
#pragma unroll
    for (int i = 0; i < 8; ++i) { ps[i] = __expf(sc[i] - mnew); lsum += ps[i]; }
    lrun = lrun * scale + lsum;
    const u32x4 pwv = {pk2(ps[0], ps[1]), pk2(ps[2], ps[3]), pk2(ps[4], ps[5]), pk2(ps[6], ps[7])};
    const bf16x8 pf = __builtin_bit_cast(bf16x8, pwv);
#pragma unroll
    for (int dt = 0; dt < 4; ++dt) { o[dt] = o[dt] * scale; o[dt] = __builtin_amdgcn_mfma_f32_16x16x32_bf16(vf[dt], pf, o[dt], 0, 0, 0); }
}

constexpr int AT_KS = 0, AT_VS = 55296;
__device__ __forceinline__ void attn_unit(const Params& P, LAS unsigned char* lds, int b, int h, int blk, int tid) {
    const int lane = tid & 63, wave = tid >> 6, qi = lane & 15, quad = lane >> 4;
    const int krow = 8 * (qi >> 2) + (qi & 3);
    unsigned char* ws = P.ws;
    const bf16_t* ZB = (const bf16_t*)(ws + WS_ZB);
    bf16_t* MIX = (bf16_t*)(ws + WS_MIX);
    const int s0 = blk * 256;
    const size_t hb = (size_t)((b * 8 + h) * 64) * SEQ;
    LAS bf16_t* Ks = (LAS bf16_t*)(lds + AT_KS); LAS bf16_t* Vs = (LAS bf16_t*)(lds + AT_VS);
    __syncthreads();
    {
        int tl = tid; asm volatile("" : "+v"(tl));
#pragma unroll
        for (int i = 0; i < 6; ++i) { const int c = tl + 512 * i; const int row = c >> 3, ch = c & 7; const int pos = s0 - 64 + row;
            u32x4 kv = {0u, 0u, 0u, 0u}, vv = kv;
            if (pos >= 0 && pos < SEQ) { const bf16_t* zp = ZB + ((size_t)b * SEQ + pos) * ZW + h * 64 + ch * 8; kv = *(const u32x4*)(zp + 512); vv = *(const u32x4*)(zp + 1024); }
            *(LAS u32x4*)(Ks + row * 72 + ch * 8) = kv;
            const int colw = row + 8 * ch; LAS bf16_t* vd = Vs + (ch * 8) * 392 + (colw >= 384 ? colw - 384 : colw);
            vd[0 * 392] = (bf16_t)(vv.x & 0xffff); vd[1 * 392] = (bf16_t)(vv.x >> 16); vd[2 * 392] = (bf16_t)(vv.y & 0xffff); vd[3 * 392] = (bf16_t)(vv.y >> 16);
            vd[4 * 392] = (bf16_t)(vv.z & 0xffff); vd[5 * 392] = (bf16_t)(vv.z >> 16); vd[6 * 392] = (bf16_t)(vv.w & 0xffff); vd[7 * 392] = (bf16_t)(vv.w >> 16); }
    }
    int jj2[2], posq[2]; size_t tokq[2];
    bf16x8 qf[2][2]; f32x4 o[2][4]; float mrun[2], lrun[2];
#pragma unroll
    for (int t = 0; t < 2; ++t) { jj2[t] = 4 * (wave >> 1) + (wave & 1) + 2 * t;     posq[t] = s0 + jj2[t] + 16 * qi; tokq[t] = (size_t)b * SEQ + posq[t];
#pragma unroll
        for (int ks = 0; ks < 2; ++ks) qf[t][ks] = *(const bf16x8*)(ZB + tokq[t] * ZW + h * 64 + ks * 32 + quad * 8);
#pragma unroll
        for (int dt = 0; dt < 4; ++dt) o[t][dt] = (f32x4){0.f, 0.f, 0.f, 0.f};
        mrun[t] = -1e30f; lrun[t] = 0.f; }
    const bf16_t* Kb = ZB + (size_t)b * SEQ * ZW + 512 + h * 64 + quad * 8;
    {
        const int dil = 16, M = 128; int r[2], mq[2]; const bf16_t* VT[2];
#pragma unroll
        for (int t = 0; t < 2; ++t) { r[t] = jj2[t]; mq[t] = blk * 16 + qi; VT[t] = (const bf16_t*)(ws + WS_VT16) + hb + r[t] * 128; }
#pragma unroll 1
        for (int st = 0; st < 2; ++st) {
            const int k0 = st * 64;
#pragma unroll
            for (int t = 0; t < 2; ++t) {
                bf16x8 kf[2][2][2], vf[2][4];
#pragma unroll
                for (int hs = 0; hs < 2; ++hs) {
#pragma unroll
                    for (int T = 0; T < 2; ++T) { const int kc = iclamp(k0 + 32 * hs + krow + 4 * T, 0, M - 1); const bf16_t* kp = Kb + (size_t)(r[t] + dil * kc) * ZW;
                        kf[hs][T][0] = *(const bf16x8*)kp; kf[hs][T][1] = *(const bf16x8*)(kp + 32); }
                    const int g = iclamp(k0 + 32 * hs + 8 * quad, 0, M - 8);
#pragma unroll
                    for (int dt = 0; dt < 4; ++dt) vf[hs][dt] = *(const bf16x8*)(VT[t] + (size_t)(dt * 16 + qi) * SEQ + g);
                }
#pragma unroll
                for (int hs = 0; hs < 2; ++hs) attn_step(kf[hs], vf[hs], qf[t], o[t], mrun[t], lrun[t], k0 + 32 * hs, M, mq[t], quad);
                __builtin_amdgcn_sched_barrier(0);
            }
        }
    }
    __syncthreads();
#pragma unroll 1
    for (int st = 0; st < 12; ++st) {
        const int kl = st * 32, k0 = s0 - 64 + kl;
        bf16x8 kf[2][2], vf[4];
#pragma unroll
        for (int T = 0; T < 2; ++T)
#pragma unroll
            for (int ks = 0; ks < 2; ++ks) kf[T][ks] = *(const LAS bf16x8*)(Ks + (kl + krow + 4 * T) * 72 + ks * 32 + quad * 8);
#pragma unroll
        for (int dt = 0; dt < 4; ++dt) { const int colr = kl + 8 * quad + 8 * (2 * dt + (qi >> 3)); vf[dt] = *(const LAS bf16x8*)(Vs + (dt * 16 + qi) * 392 + (colr >= 384 ? colr - 384 : colr)); }
#pragma unroll
        for (int t = 0; t < 2; ++t) attn_step(kf, vf, qf[t], o[t], mrun[t], lrun[t], k0, SEQ, posq[t], quad);
    }
    {
        LAS bf16_t* K4s = (LAS bf16_t*)(lds + AT_KS); LAS bf16_t* V4s = (LAS bf16_t*)(lds + AT_VS);
        const int m0 = blk * 64 - 64;
#pragma unroll
        for (int p = 0; p < 2; ++p) {
            __syncthreads();
            int tl = tid; asm volatile("" : "+v"(tl));
#pragma unroll
            for (int i = 0; i < 6; ++i) { const int c = tl + 512 * i; const int cl = c >= 1536 ? 1 : 0; const int rem = c - cl * 1536;
                const int row = rem >> 3, ch = rem & 7; const int m = m0 + row;
                u32x4 kv = {0u, 0u, 0u, 0u}, vv = kv;
                if (m >= 0 && m < 512) { const bf16_t* zp = ZB + ((size_t)b * SEQ + 4 * m + 2 * p + cl) * ZW + h * 64 + ch * 8; kv = *(const u32x4*)(zp + 512); vv = *(const u32x4*)(zp + 1024); }
                *(LAS u32x4*)(K4s + (cl * 192 + row) * 72 + ch * 8) = kv;
                const int colw = row + 8 * ch; LAS bf16_t* vd = V4s + (cl * 64 + ch * 8) * 200 + (colw >= 192 ? colw - 192 : colw);
                vd[0 * 200] = (bf16_t)(vv.x & 0xffff); vd[1 * 200] = (bf16_t)(vv.x >> 16); vd[2 * 200] = (bf16_t)(vv.y & 0xffff); vd[3 * 200] = (bf16_t)(vv.y >> 16);
                vd[4 * 200] = (bf16_t)(vv.z & 0xffff); vd[5 * 200] = (bf16_t)(vv.z >> 16); vd[6 * 200] = (bf16_t)(vv.w & 0xffff); vd[7 * 200] = (bf16_t)(vv.w >> 16); }
            __syncthreads();
            const int cl = (jj2[p] & 3) - 2 * p; const int mq = blk * 64 + (jj2[p] >> 2) + 4 * qi;
#pragma unroll 1
            for (int st = 0; st < 6; ++st) {
                const int kl = st * 32;
                bf16x8 kf[2][2], vf[4];
#pragma unroll
                for (int T = 0; T < 2; ++T)
#pragma unroll
                    for (int ks = 0; ks < 2; ++ks) kf[T][ks] = *(const LAS bf16x8*)(K4s + (cl * 192 + kl + krow + 4 * T) * 72 + ks * 32 + quad * 8);
#pragma unroll
                for (int dt = 0; dt < 4; ++dt) { const int colr = kl + 8 * quad + 8 * (2 * dt + (qi >> 3)); vf[dt] = *(const LAS bf16x8*)(V4s + (cl * 64 + dt * 16 + qi) * 200 + (colr >= 192 ? colr - 192 : colr)); }
                attn_step(kf, vf, qf[p], o[p], mrun[p], lrun[p], m0 + kl, 512, mq, quad);
            }
        }
    }
#pragma unroll
    for (int t = 0; t < 2; ++t) {
        float l = lrun[t]; l += __shfl_xor(l, 16); l += __shfl_xor(l, 32);
        const float inv = 1.0f / l;
#pragma unroll
        for (int dt = 0; dt < 4; ++dt) { u32x2 w; w.x = pk2(o[t][dt][0] * inv, o[t][dt][1] * inv); w.y = pk2(o[t][dt][2] * inv, o[t][dt][3] * inv);
            *(u32x2*)(MIX + tokq[t] * DM + h * 64 + dt * 16 + quad * 4) = w; }
    }
}

__device__ __forceinline__ void mlstm_post_row(const Params& P, int tok, int lane) {
    unsigned char* ws = P.ws;
    const bf16_t* HF = (const bf16_t*)P.out; const bf16_t* HBk = (const bf16_t*)P.out + (size_t)MTOK * 512; const bf16_t* ZB = (const bf16_t*)(ws + WS_ZB); bf16_t* MIX = (bf16_t*)(ws + WS_MIX);
    const u32x4 a = __builtin_nontemporal_load((const u32x4*)(HF + (size_t)tok * 512 + lane * 8)), c = __builtin_nontemporal_load((const u32x4*)(HBk + (size_t)tok * 512 + lane * 8));
    float v[8];
#pragma unroll
    for (int q = 0; q < 4; ++q) { v[2 * q] = bflo(a[q]) + bflo(c[q]); v[2 * q + 1] = bfhi(a[q]) + bfhi(c[q]); }
    float s = 0.f;
#pragma unroll
    for (int i = 0; i < 8; ++i) s += v[i];
#pragma unroll
    for (int o = 1; o < 16; o <<= 1) s += __shfl_xor(s, o);
    const float mu = s * (1.0f / 128.0f); float q2 = 0.f;
#pragma unroll
    for (int i = 0; i < 8; ++i) { v[i] -= mu; q2 += v[i] * v[i]; }
#pragma unroll
    for (int o = 1; o < 16; o <<= 1) q2 += __shfl_xor(q2, o);
    const float rs = rsqrtf(q2 * (1.0f / 128.0f) + EPSF);
    const u32x4 og = __builtin_nontemporal_load((const u32x4*)(ZB + (size_t)tok * ZW + 2560 + lane * 8));
    const f32x4 g0 = *(const f32x4*)(P.gn_g + lane * 8), g1 = *(const f32x4*)(P.gn_g + lane * 8 + 4);
    float y[8];
#pragma unroll
    for (int q = 0; q < 4; ++q) { const float o0 = bflo(og[q]), o1 = bfhi(og[q]); const float gg0 = q < 2 ? g0[2 * q] : g1[2 * q - 4], gg1 = q < 2 ? g0[2 * q + 1] : g1[2 * q - 3];
        y[2 * q] = v[2 * q] * rs * gg0 * sigmoidf_(o0); y[2 * q + 1] = v[2 * q + 1] * rs * gg1 * sigmoidf_(o1); }
    u32x4 w; w.x = pk2(y[0], y[1]); w.y = pk2(y[2], y[3]); w.z = pk2(y[4], y[5]); w.w = pk2(y[6], y[7]);
    *(u32x4*)(MIX + (size_t)tok * DM + 512 + lane * 8) = w;
}


#define XB_TMO      128
#define XB_XCNT(j)  (256  + 64 * (j))
#define XB_XSUB(j)  (1280 + 64 * (j))
#define XB_XGEN(j)  (2304 + 64 * (j))
#define XB_TOP      3328
#define XB_TOPGEN   3392
#define XCD_BAR_WORDS 3456
#define XB_SPIN_CAP (1u << 20)
__device__ __forceinline__ unsigned xb_ld(unsigned* p)              { return __hip_atomic_load(p, __ATOMIC_RELAXED, __HIP_MEMORY_SCOPE_AGENT); }
__device__ __forceinline__ unsigned xb_add(unsigned* p, unsigned v) { return __hip_atomic_fetch_add(p, v, __ATOMIC_RELAXED, __HIP_MEMORY_SCOPE_AGENT); }
__device__ __forceinline__ unsigned xb_xcc_id() { return (unsigned)__builtin_amdgcn_s_getreg((3 << 11) | 20) & 0xFu; }
#define XB_SPIN(cond, bar) do { unsigned _sp = 0; while (cond) { __builtin_amdgcn_s_sleep(1); \
    if ((++_sp & 255u) == 0u) { if (xb_ld(&(bar)[XB_TMO])) break; if (_sp > XB_SPIN_CAP) { atomicAdd(&(bar)[XB_TMO], 1u); break; } } } } while (0)
struct XcdBarrier { unsigned* bar; unsigned x; volatile LAS unsigned* st; };
__device__ __forceinline__ XcdBarrier xcd_barrier_post(unsigned* bar, volatile LAS unsigned* st) {
    XcdBarrier b; b.bar = bar; b.x = xb_xcc_id(); b.st = st;
    if (threadIdx.x == 0) (void)xb_add(&bar[XB_XCNT(b.x)], 1u);
    return b;
}
__device__ __forceinline__ void xcd_barrier_complete(unsigned* bar, unsigned x, unsigned& nloc, unsigned& nx) {
    const unsigned G = gridDim.x * gridDim.y * gridDim.z;
    unsigned sum, cnt, mine, sp = 0u;
    for (;;) {
        sum = 0u; cnt = 0u; mine = 0u;
#pragma unroll
        for (unsigned j = 0; j < 16; ++j) { const unsigned c = xb_ld(&bar[XB_XCNT(j)]); sum += c; cnt += (c > 0u) ? 1u : 0u; mine = (j == x) ? c : mine; }
        if (sum == G) break;
        __builtin_amdgcn_s_sleep(1);
        if ((++sp & 255u) == 0u) { if (xb_ld(&bar[XB_TMO])) break; if (sp > XB_SPIN_CAP) { atomicAdd(&bar[XB_TMO], 1u); break; } }
    }
    nloc = mine > 0u ? mine : 1u; nx = cnt > 0u ? cnt : 1u;
}
__device__ __forceinline__ void xcd_barrier(const XcdBarrier& b) {
    asm volatile("s_waitcnt vmcnt(0)" ::: "memory");
    __syncthreads();
    if (threadIdx.x == 0) {
        unsigned* bar = b.bar;
        __builtin_amdgcn_s_waitcnt(0);
        unsigned nloc = b.st[0], nx = b.st[1];
        if (nloc == 0u) { xcd_barrier_complete(bar, b.x, nloc, nx); b.st[0] = nloc; b.st[1] = nx; }
        const unsigned old = xb_add(&bar[XB_XSUB(b.x)], 1u);
        const unsigned gen = old / nloc;
        if (old + 1u == (gen + 1u) * nloc) {
            __builtin_amdgcn_fence(__ATOMIC_RELEASE, "agent");
            asm volatile("s_waitcnt vmcnt(0)" ::: "memory");
            const unsigned og = xb_add(&bar[XB_TOP], 1u);
            const unsigned tg = og / nx;
            if (og + 1u == (tg + 1u) * nx) xb_add(&bar[XB_TOPGEN], 1u);
            else XB_SPIN(xb_ld(&bar[XB_TOPGEN]) == tg, bar);
            __builtin_amdgcn_fence(__ATOMIC_ACQUIRE, "agent");
            xb_add(&bar[XB_XGEN(b.x)], 1u);
            asm volatile("s_waitcnt vmcnt(0)" ::: "memory");
        } else {
            XB_SPIN(xb_ld(&bar[XB_XGEN(b.x)]) == gen, bar);
            __builtin_amdgcn_fence(__ATOMIC_ACQUIRE, "agent");
            asm volatile("s_waitcnt vmcnt(0)" ::: "memory");
        }
    }
    __syncthreads();
}
#define GRID_SYNC() xcd_barrier(xbar)
__global__ void __launch_bounds__(512) fwd_megakernel(Params P) {
    extern __shared__ __attribute__((aligned(16))) unsigned char lds_raw[];
    LAS unsigned char* lds = (LAS unsigned char*)lds_raw;
    cg::grid_group grid = cg::this_grid();
    const int G = gridDim.x, bid = blockIdx.x;
    unsigned char* ws = P.ws;
    if (G == 0x7fffffff) grid.sync();
    { volatile LAS unsigned* stw = (volatile LAS unsigned*)(lds + LDS_ST_OFF); if (threadIdx.x < 4) stw[threadIdx.x] = 0u; }
    __syncthreads();
    const XcdBarrier xbar = xcd_barrier_post((unsigned*)(ws + WS_BAR), (volatile LAS unsigned*)(lds + LDS_ST_OFF));

    for (int rep = 0; rep < REP_MISC; ++rep) phase_prologue(P, lds, G);
    GRID_SYNC();
    {
        pg8::Gemm g{(const bf16_t*)(ws + WS_XB), (const bf16_t*)(ws + WS_WIN), MTOK, NZPAD, DM}; pg8::StaticOrder S; S.init(MTOK, NZPAD, G, bid);
        pg8::EpiZ E{(bf16_t*)(ws + WS_ZB), (float*)(ws + WS_GATES), (const float*)(ws + WS_R0), (const float*)(ws + WS_CS), (bf16_t*)(ws + WS_VT16)};
        for (int rep = 0; rep < REP_G; ++rep) pg8::gemm_phase<pg8::EpiZ, true>(lds, g, S, E);
    }
    GRID_SYNC();
#ifdef PROBE_STOP
    if (PROBE_STOP == 1) {
        int tid = threadIdx.x; asm volatile("" : "+v"(tid));
        for (size_t i = (size_t)bid * 512 + tid; i < (size_t)MTOK * DM; i += (size_t)G * 512) {
            const size_t m = i >> 10, c = i & 1023; float v;
            if (PROBE_STOP == 1) { const bf16_t* ZBp = (const bf16_t*)(ws + WS_ZB); v = bf1(ZBp[m * ZW + c]) + bf1(ZBp[m * ZW + c + 1024]) + bf1(ZBp[m * ZW + c + 2048]) + ((const float*)(ws + WS_GATES))[m * 16 + (c & 15)]; }
            else if (PROBE_STOP == 2) { v =
#ifndef PROBE_NOSCAN
 bf1(((const bf16_t*)(ws + WS_HF))[m * 512 + (c & 511)]) + bf1(((const bf16_t*)(ws + WS_HB))[m * 512 + (c & 511)]) +
#endif
 bf1(((const bf16_t*)(ws + WS_VT1))[i]) + bf1(((const bf16_t*)(ws + WS_VT4))[i]) + bf1(((const bf16_t*)(ws + WS_VT16))[i]); }
            else { v = bf1(((const bf16_t*)(ws + WS_MIX))[i]); }
            if (!(fabsf(v) < 1e30f)) v = 12345.f;
            P.out[i] = v; }
        return;
    }
#endif
    {
        int tid = threadIdx.x; asm volatile("" : "+v"(tid));
        const int nscan = G >= 256 ? 128 : (G > 1 ? G / 2 : 1);
        if (bid < nscan) for (int it = bid; it < 128; it += nscan) scan_item(P, lds, it);
        unsigned* queue = (unsigned*)(ws + WS_BAR) + 3520;
        volatile LAS unsigned* qw = (volatile LAS unsigned*)(lds + LDS_ST_OFF + 16);
        for (;;) {
            __syncthreads();
            if (tid == 0) qw[0] = __hip_atomic_fetch_add(queue, 1u, __ATOMIC_RELAXED, __HIP_MEMORY_SCOPE_AGENT);
            __syncthreads();
            const int u = (int)qw[0];
            if (u >= NB * 8 * 8) break;
            attn_unit(P, lds, u >> 6, (u >> 3) & 7, u & 7, tid);
        }
    }
    GRID_SYNC();
    {
        int tid = threadIdx.x; asm volatile("" : "+v"(tid));
        const int lane = tid & 63, wave = tid >> 6;
        for (int tok = bid * 8 + wave; tok < MTOK; tok += G * 8) mlstm_post_row(P, tok, lane);
    }
    GRID_SYNC();
    {
        pg8::Gemm g{(const bf16_t*)(ws + WS_MIX), (const bf16_t*)(ws + WS_WOUT), MTOK, DM, DM}; pg8::StaticOrder S; S.init(MTOK, DM, G, bid);
        pg8::EpiRes<true> E{nullptr, (bf16_t*)(ws + WS_XB), (float*)(ws + WS_SS1)};
        pg8::gemm_phase<pg8::EpiRes<true>, true>(lds, g, S, E);
    }
    GRID_SYNC();
    {
        pg8::Gemm g{(const bf16_t*)(ws + WS_XB), (const bf16_t*)(ws + WS_WG), MTOK, NGU, DM}; pg8::StaticOrder S; S.init(MTOK, NGU, G, bid);
        pg8::EpiGU E{(bf16_t*)(ws + WS_ACT), (const float*)(ws + WS_SS1), P.fconv_w, P.fconv_b, (float*)(ws + WS_HALO), (LAS float*)(lds + 131072)};
        pg8::gemm_phase<pg8::EpiGU, true>(lds, g, S, E);
    }
    GRID_SYNC();
    {
        int tid = threadIdx.x; asm volatile("" : "+v"(tid));
        const float* HALO = (const float*)(ws + WS_HALO); bf16_t* ACT = (bf16_t*)(ws + WS_ACT);
        for (int idx = bid * 512 + tid; idx < (MTOK / 256) * 2 * FF; idx += G * 512) {
            const int col = idx % FF; const int pe_ = idx / FF; const int e = pe_ & 1, pm = pe_ >> 1;
            const float* H = HALO + (size_t)((pm * 2 + e) * 3) * FF;
            float a = H[FF + col]; const float uu = H[2 * FF + col];
            if (e == 0) { if ((pm & 7) != 0) a += HALO[(size_t)(((pm - 1) * 2 + 1) * 3) * FF + col] * P.fconv_w[col]; }
            else        { if ((pm & 7) != 7) a += HALO[(size_t)(((pm + 1) * 2 + 0) * 3) * FF + col] * P.fconv_w[2 * FF + col]; }
            const int row = pm * 256 + (e ? 255 : 0);
            ACT[(size_t)row * FF + col] = (bf16_t)f2bf(gelu1(a) * uu);
        }
    }
    GRID_SYNC();
    {
        pg8::Gemm g{(const bf16_t*)(ws + WS_ACT), (const bf16_t*)(ws + WS_WD), MTOK, DM, FF}; pg8::StaticOrder S; S.init(MTOK, DM, G, bid);
        pg8::EpiRes<true> E{nullptr, (bf16_t*)(ws + WS_XB), (float*)(ws + WS_SS2)};
        pg8::gemm_phase<pg8::EpiRes<true>, true>(lds, g, S, E);
    }
    GRID_SYNC();
    {
        pg8::Gemm g{(const bf16_t*)(ws + WS_XB), (const bf16_t*)(ws + WS_WPG), MTOK, DM, DM}; pg8::StaticOrder S; S.init(MTOK, DM, G, bid);
        {
            int kpp = 256; asm volatile("" : "+s"(kpp));
            pg8::Gemm g2{(const bf16_t*)(ws + WS_PB), (const bf16_t*)(ws + WS_WPP), MTOK, DM, kpp}; pg8::StaticOrder S2; S2.init(MTOK, DM, G, bid);
            pg8::EpiStore E2{(bf16_t*)P.out};
            pg8::gemm_phase<pg8::EpiStore, true>(lds, g2, S2, E2);
            asm volatile("s_waitcnt vmcnt(0)" ::: "memory"); __syncthreads();
        }
        pg8::EpiSigPle E{(bf16_t*)(ws + WS_XB), (const bf16_t*)P.out, (const float*)(ws + WS_SS2), P.b_pg, (float*)(ws + WS_SS3)};
        pg8::gemm_phase<pg8::EpiSigPle, true>(lds, g, S, E);
    }
    GRID_SYNC();
    for (int rep = 0; rep < REP_SYNC; ++rep) GRID_SYNC();
    {
        int tid = threadIdx.x; asm volatile("" : "+v"(tid));
        const int lane = tid & 63, wave = tid >> 6;
        const float* ss3 = (const float*)(ws + WS_SS3);
        f32x4 gv[4];
#pragma unroll
        for (int j = 0; j < 4; ++j) gv[j] = *((const f32x4*)P.ln_f_g + lane + 64 * j);
        const int NW = G * 8;
        for (int m0 = bid * 8 + wave; m0 < MTOK; m0 += 2 * NW) {
            const int m1 = (m0 + NW < MTOK) ? m0 + NW : m0;
            u32x2 xv[2][4]; float sv[2];
#pragma unroll
            for (int q = 0; q < 2; ++q) { const int m = q ? m1 : m0; sv[q] = ss3[m]; const u32x2* xr = (const u32x2*)((const bf16_t*)(ws + WS_XB) + (size_t)m * DM) + lane;
#pragma unroll
                for (int j = 0; j < 4; ++j) xv[q][j] = __builtin_nontemporal_load(xr + 64 * j); }
#pragma unroll
            for (int q = 0; q < 2; ++q) { const int m = q ? m1 : m0;
                if (q == 1 && m1 == m0) break;
                const float r = rsqrtf(sv[q] * (1.0f / DM) + EPSF);
                f32x4* orow = (f32x4*)(P.out + (size_t)m * DM) + lane;
#pragma unroll
                for (int j = 0; j < 4; ++j) { const f32x4 v = {bflo(xv[q][j].x), bfhi(xv[q][j].x), bflo(xv[q][j].y), bfhi(xv[q][j].y)}; __builtin_nontemporal_store(v * r * gv[j], orow + 64 * j); } }
        }
    }
}

extern "C" void kernel_launch(void* const* d_in, const int* in_sizes, int n_in, void* d_out, int out_size, void* d_ws, size_t ws_size, hipStream_t stream) {
    static int grid_blocks = 0;
    if (grid_blocks == 0) {
        if (n_in != 24 || ws_size < WS_NEED) { fprintf(stderr, "kernel_launch: unexpected n_in %d / ws %zu\n", n_in, ws_size); grid_blocks = -1; return; }
        int dev = 0, cus = 0, per_cu = 0;
        hipGetDevice(&dev);
        hipDeviceGetAttribute(&cus, hipDeviceAttributeMultiprocessorCount, dev);
        if (hipFuncSetAttribute((const void*)fwd_megakernel, hipFuncAttributeMaxDynamicSharedMemorySize, LDS_BYTES) != hipSuccess) { fprintf(stderr, "hipFuncSetAttribute failed\n"); grid_blocks = -1; return; }
        if (hipOccupancyMaxActiveBlocksPerMultiprocessor(&per_cu, (const void*)fwd_megakernel, 512, LDS_BYTES) != hipSuccess || per_cu < 1) { fprintf(stderr, "occupancy query failed (%d)\n", per_cu); per_cu = 1; }
        (void)hipGetLastError();
        grid_blocks = cus * 1;
        if (grid_blocks <= 0) grid_blocks = 256;
    }
    if (grid_blocks < 0) return;
    Params P{};
    P.x = (const float*)d_in[0]; P.p = (const float*)d_in[1]; P.pos = (const int*)d_in[2];
    P.ln_mix_g = (const float*)d_in[3]; P.w_in = (const float*)d_in[4]; P.mconv_w = (const float*)d_in[5]; P.mconv_b = (const float*)d_in[6];
    P.w_mq = (const float*)d_in[7]; P.w_mk = (const float*)d_in[8]; P.b_ig = (const float*)d_in[9]; P.b_fg = (const float*)d_in[10]; P.gn_g = (const float*)d_in[11];
    P.w_out = (const float*)d_in[12]; P.ln_ffn_g = (const float*)d_in[13]; P.w_fg = (const float*)d_in[14]; P.fconv_w = (const float*)d_in[15]; P.fconv_b = (const float*)d_in[16];
    P.w_fu = (const float*)d_in[17]; P.w_fd = (const float*)d_in[18]; P.ln_ple_g = (const float*)d_in[19]; P.w_pg = (const float*)d_in[20]; P.b_pg = (const float*)d_in[21];
    P.w_pp = (const float*)d_in[22]; P.ln_f_g = (const float*)d_in[23];
    P.out = (float*)d_out; P.ws = (unsigned char*)d_ws;
    for (int j = 0; j < 8; ++j) P.invrev[j] = std::pow(500000.0, -(double)j / 8.0) / 6.283185307179586476925;
    if (hipMemsetAsync((unsigned char*)d_ws + WS_BAR, 0, 16384, stream) != hipSuccess) { fprintf(stderr, "memset failed\n"); return; }
    void* args[] = {&P};
    hipError_t e = hipLaunchCooperativeKernel((const void*)fwd_megakernel, dim3(grid_blocks), dim3(512), args, LDS_BYTES, stream);
    if (e != hipSuccess) fprintf(stderr, "cooperative launch failed: %s (grid %d)\n", hipGetErrorString(e), grid_blocks);
}
```

```cpp
#ifndef REP_ATTN
#define REP_ATTN 1
#endif
#ifndef REP_G
#define REP_G 1
#endif
#ifndef REP_MISC
#define REP_MISC 1
#endif
#ifndef REP_SYNC
#define REP_SYNC 0
#endif
#ifndef REP_SCAN
#define REP_SCAN 1
#endif
#include <hip/hip_runtime.h>
#include <hip/hip_cooperative_groups.h>
#include <cstdio>
#include <cstdint>
#include <cmath>
namespace cg = cooperative_groups;

#define LAS __attribute__((address_space(3)))
typedef unsigned short bf16_t;
typedef short bf16x8 __attribute__((ext_vector_type(8)));
typedef short bf16x4 __attribute__((ext_vector_type(4)));
typedef float f32x4 __attribute__((ext_vector_type(4)));
typedef float f32x2 __attribute__((ext_vector_type(2)));
typedef unsigned u32x4 __attribute__((ext_vector_type(4)));
typedef unsigned u32x2 __attribute__((ext_vector_type(2)));

constexpr int NB = 16, SEQ = 2048, DM = 1024, MTOK = NB * SEQ;
constexpr int ZW = 3072;
constexpr int NZPAD = 3328;
constexpr int NIN = 3088;
constexpr int FF = 2816;
constexpr int NGU = 2 * FF;
constexpr float EPSF = 1e-6f;

constexpr size_t MiB = 1u << 20;
constexpr size_t WS_R0 = 0, WS_SS1 = 128 * 1024, WS_SS2 = 256 * 1024, WS_SS3 = 384 * 1024;
constexpr size_t WS_BAR = 512 * 1024;
constexpr size_t WS_CS = 1 * MiB, WS_GATES = 3 * MiB;
constexpr size_t WS_WIN = 5 * MiB, WS_WOUT = 12 * MiB, WS_WG = 14 * MiB, WS_WU = 20 * MiB, WS_WD = 26 * MiB, WS_WPG = 32 * MiB, WS_WPP = 34 * MiB;
constexpr size_t WS_PB = 36 * MiB;
constexpr size_t WS_XB = 52 * MiB, WS_HF = 52 * MiB, WS_HB = 84 * MiB;
constexpr size_t WS_ZB = 116 * MiB;
constexpr size_t WS_VT1 = 308 * MiB, WS_VT4 = 340 * MiB, WS_VT16 = 372 * MiB;
constexpr size_t WS_MIX = 404 * MiB;
constexpr size_t WS_GP = 116 * MiB, WS_ACT = 292 * MiB, WS_SG = 116 * MiB;
constexpr size_t WS_HALO = 470 * MiB;
constexpr size_t WS_NEED = 480 * MiB;

constexpr int LDS_BYTES = 147456;
constexpr int LDS_ST_OFF = 147392;

struct Params {
    const float* x; const float* p; const int* pos;
    const float* ln_mix_g; const float* w_in; const float* mconv_w; const float* mconv_b; const float* w_mq; const float* w_mk;
    const float* b_ig; const float* b_fg; const float* gn_g; const float* w_out; const float* ln_ffn_g; const float* w_fg; const float* fconv_w; const float* fconv_b;
    const float* w_fu; const float* w_fd; const float* ln_ple_g; const float* w_pg; const float* b_pg; const float* w_pp; const float* ln_f_g;
    float* out; unsigned char* ws;
    double invrev[8];
};

typedef __bf16 bf16x2v __attribute__((ext_vector_type(2)));
__device__ __forceinline__ unsigned f2bf(float f) { return (unsigned)__builtin_bit_cast(unsigned short, (__bf16)f); }
__device__ __forceinline__ unsigned pk2(float lo, float hi) { f32x2 v = {lo, hi}; bf16x2v b = __builtin_convertvector(v, bf16x2v); return __builtin_bit_cast(unsigned, b); }
__device__ __forceinline__ float bflo(unsigned w) { return __builtin_bit_cast(float, w << 16); }
__device__ __forceinline__ float bfhi(unsigned w) { return __builtin_bit_cast(float, w & 0xffff0000u); }
__device__ __forceinline__ float bf1(bf16_t h) { return __builtin_bit_cast(float, ((unsigned)h) << 16); }
__device__ __forceinline__ float wave_sum(float v) {
#pragma unroll
    for (int o = 1; o < 64; o <<= 1) v += __shfl_xor(v, o);
    return v;
}
__device__ __forceinline__ float sigmoidf_(float x) { return 1.0f / (1.0f + __expf(-x)); }
__device__ __forceinline__ float gelu1(float v) {
    const float av = fabsf(v), d = av * 0.2316418882f + 1.0f;
    const float t = __builtin_amdgcn_rcpf(d);
    float q = t * 0.5307027145f + (-0.7265760135f); q = q * t + 0.7107068705f; q = q * t + (-0.142248368f); q = q * t + 0.127414796f; q = q * t;
    const float e = __builtin_amdgcn_exp2f((v * v) * (-0.72134752044f));
    const float m = v * (q * e), r = v - m;
    return v < 0.f ? m : r;
}

namespace pg8 {
constexpr int BM = 256, BK = 64, HALF = 128, HTB = HALF * BK * 2, STAGE_BYTES = 8 * HTB, NXCD = 8, WGM = 8;
__host__ __device__ __forceinline__ int lds_byte(int r, int c) { const int st = (r >> 4) * 2 + (c >> 5), rr = r & 15, cc = c & 31, ob = rr * 64 + cc * 2; return st * 1024 + (ob ^ (((ob >> 9) & 1) << 5)); }
__host__ __device__ __forceinline__ void stage_rc(int b, int& R, int& C) { const int st = b / 1024, sb = b % 1024, swz = sb ^ (((sb >> 9) & 1) << 5); R = (st >> 1) * 16 + swz / 64; C = (st & 1) * 32 + (swz % 64) / 2; }
__host__ __device__ __forceinline__ int perm32(int rho) { const int n = rho >> 4, i = rho & 15; return 8 * (i >> 2) + 4 * n + (i & 3); }

struct Unit { int pm, pn; };
struct Gemm { const bf16_t* A; const bf16_t* Bt; int M, N, K; };

struct StaticOrder {
    int nM, nN, nwg, G, c;
    __device__ void init(int M, int N, int G_, int c_) { nM = M / BM; nN = N / BM; nwg = nM * nN; G = G_; c = c_; }
    __device__ bool next(int i, Unit& u) const {
        const long L = (long)i * G + c; if (L >= nwg) return false;
        int wgid = (int)L; { const int q = nwg / NXCD, r = nwg % NXCD, xcd = wgid % NXCD, off = wgid / NXCD; wgid = (xcd < r ? xcd * (q + 1) : r * (q + 1) + (xcd - r) * q) + off; }
        const int nig = WGM * nN, gid = wgid / nig, fm = gid * WGM, gsz = (nM - fm) < WGM ? (nM - fm) : WGM;
        u.pm = fm + ((wgid % nig) % gsz); u.pn = (wgid % nig) / gsz; return true;
    }
};

template <class Epi, bool ALIGN_EPI>
__device__ __forceinline__ void gemm_phase(LAS unsigned char* lds, const Gemm g, const StaticOrder& S, const Epi& E) {
    int tid = threadIdx.x; asm volatile("" : "+v"(tid));
    const int wid = __builtin_amdgcn_readfirstlane(tid >> 6), lane = tid & 63, wr = wid >> 2, wc = wid & 3, fr = lane & 15, fq = lane >> 4;
    const int K = g.K, nt = K / BK;
    unsigned voffA[2], voffB[2];
#pragma unroll
    for (int i = 0; i < 2; ++i) { int R, C; stage_rc(tid * 16 + i * 8192, R, C); const int Rb = Epi::PERM ? ((R & ~31) + perm32(R & 31)) : R;
        voffA[i] = (unsigned)(R * K + C) * 2u; voffB[i] = (unsigned)(Rb * K + C) * 2u; }
    const size_t kstep = (size_t)(BK * 2);
    const size_t hstep = (size_t)HALF * K * 2;
    const size_t tstep = 2 * hstep;
    const unsigned ldsw = (unsigned)wid * 1024u;
    const int aoff = lds_byte(wr * 64 + fr, fq * 8), boff = lds_byte(wc * 32 + fr, fq * 8);
#define PG8_SA(b, h) (((b) * 2 + (h)) * HTB)
#define PG8_SB(b, h) ((4 + (b) * 2 + (h)) * HTB)
#define PG8_STAGE(bufoff, gbase, voff) do { _Pragma("unroll") for (int _i = 0; _i < 2; ++_i) \
        __builtin_amdgcn_global_load_lds((const unsigned*)((const char*)(gbase) + (voff)[_i]), (LAS unsigned*)(lds + (bufoff) + ldsw + _i * 8192), 16, 0, 0); } while (0)
#define PG8_LDA(dst, b, h) do { _Pragma("unroll") for (int m = 0; m < 4; ++m) _Pragma("unroll") for (int k = 0; k < 2; ++k) dst[m][k] = *(const LAS bf16x8*)(lds + PG8_SA(b, h) + aoff + m * 2048 + k * 1024); } while (0)
#define PG8_LDB(dst, b, h) do { _Pragma("unroll") for (int n = 0; n < 2; ++n) _Pragma("unroll") for (int k = 0; k < 2; ++k) dst[n][k] = *(const LAS bf16x8*)(lds + PG8_SB(b, h) + boff + n * 2048 + k * 1024); } while (0)
#define PG8_MMA(ai, bj, At, Bt) do { __builtin_amdgcn_s_setprio(1); _Pragma("unroll") for (int m = 0; m < 4; ++m) _Pragma("unroll") for (int n = 0; n < 2; ++n) _Pragma("unroll") for (int k = 0; k < 2; ++k) \
        acc[ai][bj][m][n] = __builtin_amdgcn_mfma_f32_16x16x32_bf16(Bt[n][k], At[m][k], acc[ai][bj][m][n], 0, 0, 0); __builtin_amdgcn_s_setprio(0); } while (0)
#define PG8_WAIT_V(n) asm volatile("s_waitcnt vmcnt(" #n ")" ::: "memory")
#define PG8_WAIT_L(n) asm volatile("s_waitcnt lgkmcnt(" #n ")" ::: "memory")
#define PG8_BAR __builtin_amdgcn_s_barrier()
#define PG8_SCHED __builtin_amdgcn_sched_barrier(0)
    Unit cur, nxt; int ui = 0;
    if (!S.next(0, cur)) return;
    f32x4 acc[2][2][4][2];
#pragma unroll
    for (int a = 0; a < 2; ++a)
#pragma unroll
        for (int b = 0; b < 2; ++b)
#pragma unroll
            for (int m = 0; m < 4; ++m)
#pragma unroll
                for (int n = 0; n < 2; ++n) acc[a][b][m][n] = (f32x4){0.f, 0.f, 0.f, 0.f};
    bf16x8 At[4][2], B0[2][2], B1[2][2];
    const char* cA = (const char*)g.A + (size_t)cur.pm * tstep; const char* cB = (const char*)g.Bt + (size_t)cur.pn * tstep;
    PG8_STAGE(PG8_SB(0, 0), cB, voffB); PG8_STAGE(PG8_SB(0, 1), cB + hstep, voffB); PG8_STAGE(PG8_SA(0, 0), cA, voffA); PG8_STAGE(PG8_SA(0, 1), cA + hstep, voffA);
    if (wr == 1) PG8_BAR;
    PG8_WAIT_V(2); PG8_BAR;
    PG8_STAGE(PG8_SB(1, 0), cB + kstep, voffB); PG8_STAGE(PG8_SA(1, 0), cA + kstep, voffA); PG8_STAGE(PG8_SB(1, 1), cB + hstep + kstep, voffB);
    PG8_WAIT_V(6); PG8_BAR;
    for (;;) {
        const bool has_next = S.next(ui + 1, nxt);
        const char* nA = has_next ? (const char*)g.A + (size_t)nxt.pm * tstep : cA; const char* nB = has_next ? (const char*)g.Bt + (size_t)nxt.pn * tstep : cB;
        for (int t = 0; t < nt; t += 2) {
            const bool last = (t == nt - 2);
            const char* a1 = cA + (size_t)(t + 1) * kstep;
            const char* a2 = last ? nA : cA + (size_t)(t + 2) * kstep; const char* b2 = last ? nB : cB + (size_t)(t + 2) * kstep;
            const char* a3 = a2 + kstep; const char* b3 = b2 + kstep;
            PG8_LDB(B0, 0, 0); PG8_LDB(B1, 0, 1); PG8_SCHED; PG8_LDA(At, 0, 0); PG8_STAGE(PG8_SA(1, 1), a1 + hstep, voffA);
            PG8_WAIT_V(8); PG8_WAIT_L(0); PG8_BAR; PG8_MMA(0, 0, At, B0); PG8_MMA(0, 1, At, B1); PG8_BAR; PG8_SCHED;
            PG8_LDA(At, 0, 1); PG8_STAGE(PG8_SB(0, 0), b2, voffB); PG8_STAGE(PG8_SB(0, 1), b2 + hstep, voffB); PG8_STAGE(PG8_SA(0, 0), a2, voffA);
            PG8_WAIT_V(8); PG8_WAIT_L(0); PG8_BAR; PG8_MMA(1, 0, At, B0); PG8_MMA(1, 1, At, B1); PG8_BAR; PG8_SCHED;
            PG8_LDB(B0, 1, 0); PG8_LDB(B1, 1, 1); PG8_SCHED; PG8_LDA(At, 1, 0); PG8_STAGE(PG8_SA(0, 1), a2 + hstep, voffA);
            PG8_WAIT_V(8); PG8_WAIT_L(0); PG8_BAR; PG8_MMA(0, 0, At, B0); PG8_MMA(0, 1, At, B1); PG8_BAR; PG8_SCHED;
            PG8_LDA(At, 1, 1); PG8_STAGE(PG8_SB(1, 0), b3, voffB); PG8_STAGE(PG8_SB(1, 1), b3 + hstep, voffB); PG8_STAGE(PG8_SA(1, 0), a3, voffA);
            PG8_WAIT_V(8); PG8_WAIT_L(0); PG8_BAR; PG8_MMA(1, 0, At, B0); PG8_MMA(1, 1, At, B1); PG8_BAR; PG8_SCHED;
        }
        if constexpr (ALIGN_EPI) { if (wr == 0) PG8_BAR; }
        E(acc, cur, wr, wc, fr, fq);
        if (!has_next) break;
#pragma unroll
        for (int a = 0; a < 2; ++a)
#pragma unroll
            for (int b = 0; b < 2; ++b)
#pragma unroll
                for (int m = 0; m < 4; ++m)
#pragma unroll
                    for (int n = 0; n < 2; ++n) acc[a][b][m][n] = (f32x4){0.f, 0.f, 0.f, 0.f};
        cur = nxt; cA = nA; cB = nB; ++ui;
        if constexpr (ALIGN_EPI) { if (wr == 1) PG8_BAR; }
    }
    PG8_WAIT_V(0);
    if constexpr (!ALIGN_EPI) { if (wr == 0) PG8_BAR; }
    PG8_BAR;
#undef PG8_SA
#undef PG8_SB
#undef PG8_STAGE
#undef PG8_LDA
#undef PG8_LDB
#undef PG8_MMA
#undef PG8_WAIT_V
#undef PG8_WAIT_L
#undef PG8_BAR
#undef PG8_SCHED
}

typedef f32x4 AccT[2][2][4][2];

struct EpiZ {
    static constexpr bool PERM = true;
    bf16_t* ZB; float* gates; const float* r0; const float* cs; bf16_t* VT16;
    __device__ __forceinline__ void operator()(const AccT& acc, const Unit& u, int wr, int wc, int fr, int fq) const {
        const int row0 = u.pm * BM + wr * 64 + fr; const int pn = u.pn;
        if (pn == 12) {
            if (wc == 0 && fq < 2) {
#pragma unroll
                for (int ai = 0; ai < 2; ++ai)
#pragma unroll
                    for (int m = 0; m < 4; ++m) { const int row = row0 + ai * HALF + m * 16; const float r = r0[row];
                        *(f32x4*)(gates + (size_t)row * 16 + 8 * fq) = acc[ai][0][m][0] * r; *(f32x4*)(gates + (size_t)row * 16 + 8 * fq + 4) = acc[ai][0][m][1] * r; }
            }
            return;
        }
        if (pn == 4 || pn == 5) {
            const int bb_ = u.pm >> 3, m16b = 16 * (u.pm & 7) + 4 * wr;
            float rr[2][4];
#pragma unroll
            for (int ai = 0; ai < 2; ++ai)
#pragma unroll
                for (int m = 0; m < 4; ++m) rr[ai][m] = r0[row0 + ai * HALF + m * 16];
#pragma unroll
            for (int bj = 0; bj < 2; ++bj) { const int hh = (pn - 4) * 4 + 2 * bj + (wc >> 1);
                bf16_t* vb = VT16 + ((size_t)((bb_ * 8 + hh) * 64 + 32 * (wc & 1) + 8 * fq)) * SEQ + fr * 128 + m16b;
#pragma unroll
                for (int ai = 0; ai < 2; ++ai)
#pragma unroll
                    for (int n = 0; n < 2; ++n)
#pragma unroll
                        for (int i = 0; i < 4; ++i) { u32x2 w;
                            w.x = pk2(acc[ai][bj][0][n][i] * rr[ai][0], acc[ai][bj][1][n][i] * rr[ai][1]); w.y = pk2(acc[ai][bj][2][n][i] * rr[ai][2], acc[ai][bj][3][n][i] * rr[ai][3]);
                            *(u32x2*)(vb + (size_t)(4 * n + i) * SEQ + 8 * ai) = w; } }
        }
        const bool rot = (pn < 4) && ((wc & 1) == 0);
        const float qs = (pn < 2) ? 0.125f : 1.0f;
        const int col0 = pn * BM + wc * 32 + 8 * fq;
#pragma unroll
        for (int ai = 0; ai < 2; ++ai)
#pragma unroll
            for (int m = 0; m < 4; ++m) { const int row = row0 + ai * HALF + m * 16; const float r = r0[row] * qs;
                f32x4 cc = {1.f, 1.f, 1.f, 1.f}, sn = {0.f, 0.f, 0.f, 0.f};
                if (rot && fq < 2) { const float* cp = cs + (size_t)row * 16 + 4 * fq; cc = *(const f32x4*)cp; sn = *(const f32x4*)(cp + 8); }
#pragma unroll
                for (int bj = 0; bj < 2; ++bj) { f32x4 v0 = acc[ai][bj][m][0] * r, v1 = acc[ai][bj][m][1] * r;
                    if (rot) { const f32x4 t1 = v0, t2 = v1; v0 = t1 * cc - t2 * sn; v1 = t2 * cc + t1 * sn; }
                    u32x4 w; w.x = pk2(v0[0], v0[1]); w.y = pk2(v0[2], v0[3]); w.z = pk2(v1[0], v1[1]); w.w = pk2(v1[2], v1[3]);
                    *(u32x4*)(ZB + (size_t)row * ZW + col0 + bj * HALF) = w; } }
    }
};

template <bool BASE_BF16> struct EpiRes {
    static constexpr bool PERM = true;
    const float* basef; bf16_t* xb; float* ss;
    __device__ __forceinline__ void operator()(const AccT& acc, const Unit& u, int wr, int wc, int fr, int fq) const {
        const int row0 = u.pm * BM + wr * 64 + fr; const int col0 = u.pn * BM + wc * 32 + 8 * fq;
#pragma unroll
        for (int ai = 0; ai < 2; ++ai)
#pragma unroll
            for (int m = 0; m < 4; ++m) { const int row = row0 + ai * HALF + m * 16; float sq = 0.f;
#pragma unroll
                for (int bj = 0; bj < 2; ++bj) { const size_t off = (size_t)row * DM + col0 + bj * HALF;
                    f32x4 b0, b1;
                    if (BASE_BF16) { const u32x4 g = *(const u32x4*)(xb + off); b0 = (f32x4){bflo(g.x), bfhi(g.x), bflo(g.y), bfhi(g.y)}; b1 = (f32x4){bflo(g.z), bfhi(g.z), bflo(g.w), bfhi(g.w)}; }
                    else { b0 = *(const f32x4*)(basef + off); b1 = *(const f32x4*)(basef + off + 4); }
                    const f32x4 v0 = b0 + acc[ai][bj][m][0], v1 = b1 + acc[ai][bj][m][1];
                    u32x4 w; w.x = pk2(v0[0], v0[1]); w.y = pk2(v0[2], v0[3]); w.z = pk2(v1[0], v1[1]); w.w = pk2(v1[2], v1[3]);
                    *(u32x4*)(xb + off) = w;
                    sq += (v0[0] * v0[0] + v0[1] * v0[1]) + (v0[2] * v0[2] + v0[3] * v0[3]) + (v1[0] * v1[0] + v1[1] * v1[1]) + (v1[2] * v1[2] + v1[3] * v1[3]); }
                sq += __shfl_xor(sq, 16); sq += __shfl_xor(sq, 32);
                if (fq == 0) atomicAdd(ss + row, sq); }
    }
};

struct EpiGate {
    static constexpr bool PERM = true;
    bf16_t* GP; const float* ss;
    __device__ __forceinline__ void operator()(const AccT& acc, const Unit& u, int wr, int wc, int fr, int fq) const {
        const int row0 = u.pm * BM + wr * 64 + fr; const int col0 = u.pn * BM + wc * 32 + 8 * fq;
#pragma unroll
        for (int ai = 0; ai < 2; ++ai)
#pragma unroll
            for (int m = 0; m < 4; ++m) { const int row = row0 + ai * HALF + m * 16; const float r = rsqrtf(ss[row] * (1.0f / DM) + EPSF);
#pragma unroll
                for (int bj = 0; bj < 2; ++bj) { const f32x4 v0 = acc[ai][bj][m][0] * r, v1 = acc[ai][bj][m][1] * r;
                    u32x4 w; w.x = pk2(v0[0], v0[1]); w.y = pk2(v0[2], v0[3]); w.z = pk2(v1[0], v1[1]); w.w = pk2(v1[2], v1[3]);
                    *(u32x4*)(GP + (size_t)row * FF + col0 + bj * HALF) = w; } }
    }
};

struct EpiUp {
    static constexpr bool PERM = true;
    const bf16_t* GP; bf16_t* ACT; const float* ss; const float* cw; const float* cb;
    __device__ __forceinline__ void operator()(const AccT& acc, const Unit& u, int wr, int wc, int fr, int fq) const {
        const int row0 = u.pm * BM + wr * 64 + fr; const int col0 = u.pn * BM + wc * 32 + 8 * fq;
#pragma unroll
        for (int bj = 0; bj < 2; ++bj) { const int col = col0 + bj * HALF;
            f32x4 w0[2], w1[2], w2[2], bb[2];
#pragma unroll
            for (int n = 0; n < 2; ++n) { w0[n] = *(const f32x4*)(cw + col + 4 * n); w1[n] = *(const f32x4*)(cw + FF + col + 4 * n); w2[n] = *(const f32x4*)(cw + 2 * FF + col + 4 * n); bb[n] = *(const f32x4*)(cb + col + 4 * n); }
#pragma unroll
            for (int ai = 0; ai < 2; ++ai)
#pragma unroll
                for (int m = 0; m < 4; ++m) { const int row = row0 + ai * HALF + m * 16; const int s = row & (SEQ - 1); const float r = rsqrtf(ss[row] * (1.0f / DM) + EPSF);
                    const bf16_t* gp = GP + (size_t)row * FF + col;
                    const u32x4 gc = *(const u32x4*)gp;
                    u32x4 gm = {0u, 0u, 0u, 0u}, gn = {0u, 0u, 0u, 0u};
                    if (s > 0) gm = *(const u32x4*)(gp - FF);
                    if (s < SEQ - 1) gn = *(const u32x4*)(gp + FF);
                    float y[8];
#pragma unroll
                    for (int q = 0; q < 4; ++q) { const int n = q >> 1, i0 = (q & 1) * 2;
                        const float a0 = bflo(gm[q]) * w0[n][i0] + bflo(gc[q]) * w1[n][i0] + bflo(gn[q]) * w2[n][i0] + bb[n][i0];
                        const float a1 = bfhi(gm[q]) * w0[n][i0 + 1] + bfhi(gc[q]) * w1[n][i0 + 1] + bfhi(gn[q]) * w2[n][i0 + 1] + bb[n][i0 + 1];
                        y[2 * q] = gelu1(a0) * (acc[ai][bj][m][n][i0] * r); y[2 * q + 1] = gelu1(a1) * (acc[ai][bj][m][n][i0 + 1] * r); }
                    u32x4 w; w.x = pk2(y[0], y[1]); w.y = pk2(y[2], y[3]); w.z = pk2(y[4], y[5]); w.w = pk2(y[6], y[7]);
                    *(u32x4*)(ACT + (size_t)row * FF + col) = w; } }
    }
};

__device__ __forceinline__ float dpp_ror1(float v) { return __builtin_bit_cast(float, __builtin_amdgcn_update_dpp(0, __builtin_bit_cast(int, v), 0x121, 0xF, 0xF, false)); }
__device__ __forceinline__ float dpp_rol1(float v) { return __builtin_bit_cast(float, __builtin_amdgcn_update_dpp(0, __builtin_bit_cast(int, v), 0x12F, 0xF, 0xF, false)); }
struct EpiGU {
    static constexpr bool PERM = true;
    bf16_t* ACT; const float* ss; const float* cw; const float* cb; float* HALO; LAS float* E;
    __device__ __forceinline__ void operator()(const AccT& acc, const Unit& u, int wr, int wc, int fr, int fq) const {
        const int row0 = u.pm * BM + wr * 64 + fr; const int ecol = wc * 32 + 8 * fq; const int colg = u.pn * 128 + ecol;
        float rr[2][4];
#pragma unroll
        for (int ai = 0; ai < 2; ++ai)
#pragma unroll
            for (int m = 0; m < 4; ++m) rr[ai][m] = rsqrtf(ss[row0 + ai * HALF + m * 16] * (1.0f / DM) + EPSF);
#pragma unroll
        for (int ai = 0; ai < 2; ++ai) { const int k = 2 * ai + wr;
            if (fr == 0) { *(LAS f32x4*)(E + (k * 2 + 0) * 128 + ecol) = acc[ai][0][0][0] * rr[ai][0]; *(LAS f32x4*)(E + (k * 2 + 0) * 128 + ecol + 4) = acc[ai][0][0][1] * rr[ai][0]; }
            if (fr == 15) { *(LAS f32x4*)(E + (k * 2 + 1) * 128 + ecol) = acc[ai][0][3][0] * rr[ai][3]; *(LAS f32x4*)(E + (k * 2 + 1) * 128 + ecol + 4) = acc[ai][0][3][1] * rr[ai][3]; } }
        asm volatile("s_waitcnt lgkmcnt(0)" ::: "memory"); __builtin_amdgcn_s_barrier(); asm volatile("" ::: "memory");
        f32x4 w0[2], w1[2], w2[2], bb[2];
#pragma unroll
        for (int n = 0; n < 2; ++n) { w0[n] = *(const f32x4*)(cw + colg + 4 * n); w1[n] = *(const f32x4*)(cw + FF + colg + 4 * n); w2[n] = *(const f32x4*)(cw + 2 * FF + colg + 4 * n); bb[n] = *(const f32x4*)(cb + colg + 4 * n); }
#pragma unroll
        for (int ai = 0; ai < 2; ++ai) { const int k = 2 * ai + wr;
            f32x4 pe[2], ne[2];
#pragma unroll
            for (int n = 0; n < 2; ++n) { pe[n] = (f32x4){0.f, 0.f, 0.f, 0.f}; ne[n] = pe[n];
                if (k > 0) pe[n] = *(const LAS f32x4*)(E + ((k - 1) * 2 + 1) * 128 + ecol + 4 * n);
                if (k < 3) ne[n] = *(const LAS f32x4*)(E + ((k + 1) * 2 + 0) * 128 + ecol + 4 * n); }
            f32x4 g[4][2];
#pragma unroll
            for (int m = 0; m < 4; ++m)
#pragma unroll
                for (int n = 0; n < 2; ++n) g[m][n] = acc[ai][0][m][n] * rr[ai][m];
            f32x4 rorPrev[2] = {pe[0], pe[1]}, rolCur[2];
#pragma unroll
            for (int n = 0; n < 2; ++n)
#pragma unroll
                for (int i = 0; i < 4; ++i) rolCur[n][i] = dpp_rol1(g[0][n][i]);
#pragma unroll
            for (int m = 0; m < 4; ++m) { const int row = row0 + ai * HALF + m * 16;
                f32x4 pv[2], nv[2], rolNext[2];
#pragma unroll
                for (int n = 0; n < 2; ++n)
#pragma unroll
                    for (int i = 0; i < 4; ++i) { const float rc = dpp_ror1(g[m][n][i]); pv[n][i] = fr > 0 ? rc : rorPrev[n][i]; rorPrev[n][i] = rc;
                        rolNext[n][i] = (m < 3) ? dpp_rol1(g[m < 3 ? m + 1 : 3][n][i]) : ne[n][i]; nv[n][i] = fr < 15 ? rolCur[n][i] : rolNext[n][i]; rolCur[n][i] = rolNext[n][i]; }
                const bool top = (k == 0 && m == 0 && fr == 0), bot = (k == 3 && m == 3 && fr == 15);
                float y[8];
#pragma unroll
                for (int n = 0; n < 2; ++n) { const f32x4 uu = acc[ai][1][m][n] * rr[ai][m];
                    const f32x4 amid = g[m][n] * w1[n] + bb[n]; const f32x4 a = pv[n] * w0[n] + (amid + nv[n] * w2[n]);
#pragma unroll
                    for (int i = 0; i < 4; ++i) y[4 * n + i] = gelu1(a[i]) * uu[i];
                    if (top) { float* H = HALO + (size_t)((u.pm * 2 + 0) * 3) * FF + colg + 4 * n; *(f32x4*)H = g[m][n]; *(f32x4*)(H + FF) = amid + nv[n] * w2[n]; *(f32x4*)(H + 2 * FF) = uu; }
                    if (bot) { float* H = HALO + (size_t)((u.pm * 2 + 1) * 3) * FF + colg + 4 * n; *(f32x4*)H = g[m][n]; *(f32x4*)(H + FF) = pv[n] * w0[n] + amid; *(f32x4*)(H + 2 * FF) = uu; } }
                u32x4 w; w.x = pk2(y[0], y[1]); w.y = pk2(y[2], y[3]); w.z = pk2(y[4], y[5]); w.w = pk2(y[6], y[7]);
                *(u32x4*)(ACT + (size_t)row * FF + colg) = w; }
        }
    }
};

struct EpiStore {
    static constexpr bool PERM = true;
    bf16_t* O;
    __device__ __forceinline__ void operator()(const AccT& acc, const Unit& u, int wr, int wc, int fr, int fq) const {
        const int row0 = u.pm * BM + wr * 64 + fr; const int col0 = u.pn * BM + wc * 32 + 8 * fq;
#pragma unroll
        for (int ai = 0; ai < 2; ++ai)
#pragma unroll
            for (int m = 0; m < 4; ++m) { const int row = row0 + ai * HALF + m * 16;
#pragma unroll
                for (int bj = 0; bj < 2; ++bj) { const f32x4 v0 = acc[ai][bj][m][0], v1 = acc[ai][bj][m][1];
                    u32x4 w; w.x = pk2(v0[0], v0[1]); w.y = pk2(v0[2], v0[3]); w.z = pk2(v1[0], v1[1]); w.w = pk2(v1[2], v1[3]);
                    *(u32x4*)(O + (size_t)row * DM + col0 + bj * HALF) = w; } }
    }
};

struct EpiSigPle {
    static constexpr bool PERM = true;
    bf16_t* xb; const bf16_t* PP; const float* ssin; const float* bias; float* ss;
    __device__ __forceinline__ void operator()(const AccT& acc, const Unit& u, int wr, int wc, int fr, int fq) const {
        const int row0 = u.pm * BM + wr * 64 + fr; const int col0 = u.pn * BM + wc * 32 + 8 * fq;
#pragma unroll
        for (int ai = 0; ai < 2; ++ai)
#pragma unroll
            for (int m = 0; m < 4; ++m) { const int row = row0 + ai * HALF + m * 16; const float r = rsqrtf(ssin[row] * (1.0f / DM) + EPSF); float sq = 0.f;
#pragma unroll
                for (int bj = 0; bj < 2; ++bj) { const size_t off = (size_t)row * DM + col0 + bj * HALF;
                    const u32x4 xbv = *(const u32x4*)(xb + off); const u32x4 pv = *(const u32x4*)(PP + off);
                    const f32x4 x0 = {bflo(xbv.x), bfhi(xbv.x), bflo(xbv.y), bfhi(xbv.y)}, x1 = {bflo(xbv.z), bfhi(xbv.z), bflo(xbv.w), bfhi(xbv.w)};
                    const f32x4 p0 = {bflo(pv.x), bfhi(pv.x), bflo(pv.y), bfhi(pv.y)}, p1 = {bflo(pv.z), bfhi(pv.z), bflo(pv.w), bfhi(pv.w)};
                    const f32x4 a0 = acc[ai][bj][m][0] * r + *(const f32x4*)(bias + col0 + bj * HALF), a1 = acc[ai][bj][m][1] * r + *(const f32x4*)(bias + col0 + bj * HALF + 4);
                    const f32x4 s0 = {sigmoidf_(a0[0]), sigmoidf_(a0[1]), sigmoidf_(a0[2]), sigmoidf_(a0[3])}, s1 = {sigmoidf_(a1[0]), sigmoidf_(a1[1]), sigmoidf_(a1[2]), sigmoidf_(a1[3])};
                    const f32x4 v0 = x0 + p0 * s0, v1 = x1 + p1 * s1;
                    u32x4 w; w.x = pk2(v0[0], v0[1]); w.y = pk2(v0[2], v0[3]); w.z = pk2(v1[0], v1[1]); w.w = pk2(v1[2], v1[3]);
                    *(u32x4*)(xb + off) = w;
                    sq += (v0[0] * v0[0] + v0[1] * v0[1]) + (v0[2] * v0[2] + v0[3] * v0[3]) + (v1[0] * v1[0] + v1[1] * v1[1]) + (v1[2] * v1[2] + v1[3] * v1[3]); }
                sq += __shfl_xor(sq, 16); sq += __shfl_xor(sq, 32);
                if (fq == 0) atomicAdd(ss + row, sq);
                asm volatile("" ::: "memory"); }
    }
};
}

__device__ __forceinline__ void transpose_item(const float* W, int K, int N, int nblk, const float* gk, bf16_t* WT, LAS float* scr, int item, int lane, int rowmode = 0) {
    const int kb = item / nblk, nb = item % nblk, k0 = 64 * kb, n0 = 32 * nb;
    const int d0 = (rowmode == 1 || rowmode == 2) ? (256 * (n0 >> 7) + (n0 & 127) + (rowmode == 2 ? 128 : 0)) : n0;
    const int n = n0 + (lane & 31);
#pragma unroll 8
    for (int i = 0; i < 32; ++i) { const int kk = 2 * i + (lane >> 5); float v = 0.f; if (n < N) v = __builtin_nontemporal_load(&W[(size_t)(k0 + kk) * N + n]); if (gk) v *= gk[k0 + kk]; scr[kk * 33 + (lane & 31)] = v; }
    asm volatile("s_waitcnt lgkmcnt(0)" ::: "memory");
    const int c = lane & 7;
#pragma unroll
    for (int j = 0; j < 4; ++j) { const int nn = (lane >> 3) + 8 * j; const LAS float* s = scr + (8 * c) * 33 + nn;
        u32x4 o; o.x = pk2(s[0 * 33], s[1 * 33]); o.y = pk2(s[2 * 33], s[3 * 33]); o.z = pk2(s[4 * 33], s[5 * 33]); o.w = pk2(s[6 * 33], s[7 * 33]);
        const int nd = (rowmode == 3 && n0 < 1024 && (n0 & 63) == 0 && nn >= 4 && nn < 12) ? (nn ^ 12) : nn;
        *(u32x4*)(WT + (size_t)(d0 + nd) * K + k0 + 8 * c) = o; }
    asm volatile("s_waitcnt lgkmcnt(0)" ::: "memory");
}

__device__ __forceinline__ void phase_prologue(const Params& P, LAS unsigned char* lds, int G) {
    int tid = threadIdx.x; asm volatile("" : "+v"(tid));
    const int lane = tid & 63, wave = tid >> 6;
    const int gw = blockIdx.x * 8 + wave, NGW = G * 8;
    unsigned char* ws = P.ws;
    LAS float* scr = (LAS float*)(lds + wave * 16384);
    constexpr int I_IN = 16 * (NZPAD / 32), I_OUT = 16 * 32, I_G = 16 * (FF / 32), I_D = (FF / 64) * 32, I_PP = 4 * 32;
    constexpr int NITEMS = I_IN + I_OUT + 2 * I_G + I_D + I_OUT + I_PP;
    for (int it = gw; it < NITEMS; it += NGW) {
        int r = it;
        if (r < I_IN) { transpose_item(P.w_in, DM, NIN, NZPAD / 32, P.ln_mix_g, (bf16_t*)(ws + WS_WIN), scr, r, lane, 3); continue; } r -= I_IN;
        if (r < I_OUT) { transpose_item(P.w_out, DM, DM, 32, nullptr, (bf16_t*)(ws + WS_WOUT), scr, r, lane); continue; } r -= I_OUT;
        if (r < I_G) { transpose_item(P.w_fg, DM, FF, FF / 32, P.ln_ffn_g, (bf16_t*)(ws + WS_WG), scr, r, lane, 1); continue; } r -= I_G;
        if (r < I_G) { transpose_item(P.w_fu, DM, FF, FF / 32, P.ln_ffn_g, (bf16_t*)(ws + WS_WG), scr, r, lane, 2); continue; } r -= I_G;
        if (r < I_D) { transpose_item(P.w_fd, FF, DM, 32, nullptr, (bf16_t*)(ws + WS_WD), scr, r, lane); continue; } r -= I_D;
        if (r < I_OUT) { transpose_item(P.w_pg, DM, DM, 32, P.ln_ple_g, (bf16_t*)(ws + WS_WPG), scr, r, lane); continue; } r -= I_OUT;
        transpose_item(P.w_pp, 256, DM, 32, nullptr, (bf16_t*)(ws + WS_WPP), scr, r, lane);
    }
    float* r0 = (float*)(ws + WS_R0); float* cs = (float*)(ws + WS_CS);
    bf16_t* XB = (bf16_t*)(ws + WS_XB); bf16_t* PB = (bf16_t*)(ws + WS_PB);
    for (int m0 = gw; m0 < MTOK; m0 += 2 * NGW) {
        const int m1 = (m0 + NGW < MTOK) ? m0 + NGW : m0;
        f32x4 v[2][4]; f32x4 pv[2]; int ps[2];
#pragma unroll
        for (int q = 0; q < 2; ++q) { const int m = q ? m1 : m0; const f32x4* xr = (const f32x4*)(P.x + (size_t)m * DM) + lane;
#pragma unroll
            for (int j = 0; j < 4; ++j) v[q][j] = __builtin_nontemporal_load(xr + 64 * j);
            pv[q] = __builtin_nontemporal_load((const f32x4*)(P.p + (size_t)m * 256) + lane); ps[q] = P.pos[m]; }
#pragma unroll
        for (int q = 0; q < 2; ++q) { const int m = q ? m1 : m0;
            if (q == 1 && m1 == m0) break;
            float s = 0.f;
#pragma unroll
            for (int j = 0; j < 4; ++j) s += (v[q][j].x * v[q][j].x + v[q][j].y * v[q][j].y) + (v[q][j].z * v[q][j].z + v[q][j].w * v[q][j].w);
            s = wave_sum(s);
            u32x2* o8 = (u32x2*)(XB + (size_t)m * DM) + lane;
#pragma unroll
            for (int j = 0; j < 4; ++j) { u32x2 w; w.x = pk2(v[q][j].x, v[q][j].y); w.y = pk2(v[q][j].z, v[q][j].w); o8[64 * j] = w; }
            if (lane == 0) r0[m] = rsqrtf(s * (1.0f / DM) + EPSF);
            u32x2 pw; pw.x = pk2(pv[q].x, pv[q].y); pw.y = pk2(pv[q].z, pv[q].w);
            *((u32x2*)(PB + (size_t)m * 256) + lane) = pw;
            if (lane < 8) {
                const double rev = (double)ps[q] * P.invrev[lane];
                const float fr = (float)(rev - floor(rev));
                cs[(size_t)m * 16 + lane] = __builtin_amdgcn_cosf(fr);
                cs[(size_t)m * 16 + 8 + lane] = __builtin_amdgcn_sinf(fr);
            } }
    }
    float* ssz = (float*)(ws + WS_SS1);
    for (int i = blockIdx.x * 512 + tid; i < 3 * MTOK; i += G * 512) ssz[i] = 0.f;
}

__device__ __forceinline__ void vtrans_unit(const Params& P, LAS unsigned char* lds, int unit) {
    int tid = threadIdx.x; asm volatile("" : "+v"(tid));
    const int blk = unit & 7, h = (unit >> 3) & 7, b = unit >> 6;
    const int s0 = blk * 256;
    unsigned char* ws = P.ws;
    const bf16_t* ZB = (const bf16_t*)(ws + WS_ZB);
    LAS bf16_t* tile = (LAS bf16_t*)lds;
    __syncthreads();
#pragma unroll
    for (int i = 0; i < 4; ++i) { const int ch = tid + 512 * i; const int t = ch >> 3, dc = ch & 7;
        const u32x4 v = *(const u32x4*)(ZB + (size_t)(b * SEQ + s0 + t) * ZW + 1024 + h * 64 + dc * 8);
        LAS unsigned* dst = (LAS unsigned*)(tile + t * 66 + dc * 8);
        dst[0] = v.x; dst[1] = v.y; dst[2] = v.z; dst[3] = v.w; }
    __syncthreads();
    const size_t hb = (size_t)((b * 8 + h) * 64) * SEQ;
    bf16_t* V1 = (bf16_t*)(ws + WS_VT1) + hb; bf16_t* V4 = (bf16_t*)(ws + WS_VT4) + hb; bf16_t* V16 = (bf16_t*)(ws + WS_VT16) + hb;
#pragma unroll
    for (int i = 0; i < 4; ++i) { const int ch = tid + 512 * i; const int d = ch >> 5, t8 = ch & 31;
        unsigned short e[8];
#pragma unroll
        for (int k = 0; k < 8; ++k) e[k] = tile[(t8 * 8 + k) * 66 + d];
        u32x4 w; w.x = e[0] | ((unsigned)e[1] << 16); w.y = e[2] | ((unsigned)e[3] << 16); w.z = e[4] | ((unsigned)e[5] << 16); w.w = e[6] | ((unsigned)e[7] << 16);
        *(u32x4*)(V1 + (size_t)d * SEQ + s0 + t8 * 8) = w; }
#pragma unroll
    for (int i = 0; i < 4; ++i) { const int ch = tid + 512 * i; const int d = ch >> 5, r = (ch >> 3) & 3, m8 = ch & 7;
        unsigned short e[8];
#pragma unroll
        for (int k = 0; k < 8; ++k) e[k] = tile[(4 * (m8 * 8 + k) + r) * 66 + d];
        u32x4 w; w.x = e[0] | ((unsigned)e[1] << 16); w.y = e[2] | ((unsigned)e[3] << 16); w.z = e[4] | ((unsigned)e[5] << 16); w.w = e[6] | ((unsigned)e[7] << 16);
        *(u32x4*)(V4 + (size_t)d * SEQ + r * 512 + (s0 >> 2) + m8 * 8) = w; }
#pragma unroll
    for (int i = 0; i < 4; ++i) { const int ch = tid + 512 * i; const int d = ch >> 5, r = (ch >> 1) & 15, m8 = ch & 1;
        unsigned short e[8];
#pragma unroll
        for (int k = 0; k < 8; ++k) e[k] = tile[(16 * (m8 * 8 + k) + r) * 66 + d];
        u32x4 w; w.x = e[0] | ((unsigned)e[1] << 16); w.y = e[2] | ((unsigned)e[3] << 16); w.z = e[4] | ((unsigned)e[5] << 16); w.w = e[6] | ((unsigned)e[7] << 16);
        *(u32x4*)(V16 + (size_t)d * SEQ + r * 128 + (s0 >> 4) + m8 * 8) = w; }
}

constexpr int SC_UC = 0, SC_P = 0  , SC_Q = 17408, SC_K = 34816, SC_KW = 52224, SC_VT = 70656, SC_CB = 91392, SC_F = 130560;
constexpr int NE = 144, NCT = 9;
__device__ __forceinline__ void scan_item(const Params& P, LAS unsigned char* lds, int item) {
    int tid = threadIdx.x; asm volatile("" : "+v"(tid));
    const int lane = tid & 63, w = __builtin_amdgcn_readfirstlane(tid >> 6), qi = lane & 15, quad = lane >> 4;
    const int dir = item & 1, h = (item >> 1) & 3, b = item >> 3;
    unsigned char* ws = P.ws;
    const bf16_t* ZB = (const bf16_t*)(ws + WS_ZB);
    const float* gates = (const float*)(ws + WS_GATES);
    bf16_t* HB = (bf16_t*)P.out + (dir ? (size_t)MTOK * 512 : 0);
    LAS bf16_t* ucS = (LAS bf16_t*)(lds + SC_UC); LAS bf16_t* qS = (LAS bf16_t*)(lds + SC_Q); LAS bf16_t* kS = (LAS bf16_t*)(lds + SC_K);
    LAS bf16_t* kwT = (LAS bf16_t*)(lds + SC_KW); LAS bf16_t* vT = (LAS bf16_t*)(lds + SC_VT); LAS bf16_t* pS = (LAS bf16_t*)(lds + SC_P); LAS bf16_t* CbT = (LAS bf16_t*)(lds + SC_CB);
    LAS float* cS = (LAS float*)(lds + SC_F); LAS float* MS = cS + 64; LAS float* aS = cS + 128; LAS float* eS = cS + 192; LAS float* wS = cS + 256; LAS float* denS = cS + 320; LAS float* misc = cS + 384;
    __syncthreads();
    bf16x8 wqf[4], wkf[4];
    {
        const float* wq = P.w_mq + (size_t)h * 128 * 128 + 16 * w + qi; const float* wk = P.w_mk + (size_t)h * 128 * 128 + 16 * w + qi;
        const float ksc = 0.08838834764831845f;
#pragma unroll
        for (int ks = 0; ks < 4; ++ks)
#pragma unroll
            for (int i = 0; i < 8; ++i) { const int d = ks * 32 + quad * 8 + i; wqf[ks][i] = (short)f2bf(wq[(size_t)d * 128]); wkf[ks][i] = (short)f2bf(wk[(size_t)d * 128] * ksc); }
    }
    for (int i = tid; i < NE * 136 / 2; i += 512) ((LAS unsigned*)CbT)[i] = 0u;
    for (int i = tid; i < 16 * 72; i += 512) vT[128 * 72 + i] = (i < 72) ? (bf16_t)0x3F80 : (bf16_t)0;
    f32x4 C[NCT];
#pragma unroll
    for (int ct = 0; ct < NCT; ++ct) C[ct] = (f32x4){0.f, 0.f, 0.f, 0.f};
    float m_run = 0.f;
    const float big = P.b_ig[dir * 4 + h], bfg = P.b_fg[dir * 4 + h];
    __syncthreads();
    u32x4 uc0, uc1, um0, um1, un0, un1, vvA, vvB; float pig = 0.f, pfg = 0.f;
#define SCAN_PREFETCH(cidx) do { const int cc_ = dir ? 31 - (cidx) : (cidx); const int t0_ = cc_ * 64; \
        { const int s_ = tid >> 3, dc_ = tid & 7; const int pos_ = dir ? t0_ + 63 - s_ : t0_ + s_; const size_t tok_ = (size_t)b * SEQ + pos_; \
          const bf16_t* up_ = ZB + tok_ * ZW + 1536 + h * 128 + dc_ * 16; \
          uc0 = *(const u32x4*)up_; uc1 = *(const u32x4*)(up_ + 8); \
          um0 = (u32x4){0u, 0u, 0u, 0u}; um1 = um0; un0 = um0; un1 = um0; \
          if (pos_ > 0) { um0 = *(const u32x4*)(up_ - ZW); um1 = *(const u32x4*)(up_ - ZW + 8); } \
          if (pos_ < SEQ - 1) { un0 = *(const u32x4*)(up_ + ZW); un1 = *(const u32x4*)(up_ + ZW + 8); } \
          vvA = *(const u32x4*)(ZB + tok_ * ZW + 2048 + h * 128 + dc_ * 16); vvB = *(const u32x4*)(ZB + tok_ * ZW + 2048 + h * 128 + dc_ * 16 + 8); } \
        if (w == 0) { const int pos_ = dir ? t0_ + 63 - lane : t0_ + lane; const size_t tok_ = (size_t)b * SEQ + pos_; \
          pig = gates[tok_ * 16 + dir * 4 + h]; pfg = gates[tok_ * 16 + 8 + dir * 4 + h]; } } while (0)
    SCAN_PREFETCH(0);
    for (int c = 0; c < 32; ++c) {
        const int cc = dir ? 31 - c : c; const int t0 = cc * 64;
        if (w == 0) {
            const float ig = pig + big; const float fg = pfg + bfg;
            const float lf = fminf(fg, 0.f) - log1pf(__expf(-fabsf(fg)));
            float bs = lf;
#pragma unroll
            for (int o = 1; o < 64; o <<= 1) { const float t = __shfl_up(bs, o); if (lane >= o) bs += t; }
            const float cv = ig - bs; float pm = cv;
#pragma unroll
            for (int o = 1; o < 64; o <<= 1) { const float t = __shfl_up(pm, o); if (lane >= o) pm = fmaxf(pm, t); }
            const float Mt = fmaxf(m_run, pm);
            const float M63 = __shfl(Mt, 63), g = __shfl(bs, 63);
            cS[lane] = cv; MS[lane] = Mt; aS[lane] = __expf(m_run - Mt); eS[lane] = __expf(-(bs + Mt)); wS[lane] = __expf(cv - M63);
            if (lane == 0) misc[0] = __expf(m_run - M63);
            m_run = g + M63;
        }
        {
            const int s = tid >> 3, dc = tid & 7; const int pos = dir ? t0 + 63 - s : t0 + s; const size_t tok = (size_t)b * SEQ + pos;
            const int ch = h * 128 + dc * 16;
            unsigned ow[8];
#pragma unroll
            for (int q = 0; q < 8; ++q) { const unsigned m_ = q < 4 ? um0[q & 3] : um1[q & 3], c_ = q < 4 ? uc0[q & 3] : uc1[q & 3], n_ = q < 4 ? un0[q & 3] : un1[q & 3];
                const int cch = ch + 2 * q;
                const float a0 = bflo(m_) * P.mconv_w[cch] + bflo(c_) * P.mconv_w[512 + cch] + bflo(n_) * P.mconv_w[1024 + cch] + P.mconv_b[cch];
                const float a1 = bfhi(m_) * P.mconv_w[cch + 1] + bfhi(c_) * P.mconv_w[512 + cch + 1] + bfhi(n_) * P.mconv_w[1024 + cch + 1] + P.mconv_b[cch + 1];
                ow[q] = pk2(a0 * sigmoidf_(a0), a1 * sigmoidf_(a1)); }
            LAS u32x4* dst = (LAS u32x4*)(ucS + s * 136 + dc * 16);
            dst[0] = (u32x4){ow[0], ow[1], ow[2], ow[3]}; dst[1] = (u32x4){ow[4], ow[5], ow[6], ow[7]};
            const int e0 = dc * 16;
            const int sc_ = (s + 8 * dc) & 63;
#pragma unroll
            for (int q = 0; q < 4; ++q) { const unsigned wa = vvA[q], wb = vvB[q];
                vT[(e0 + 2 * q) * 72 + sc_] = (bf16_t)(wa & 0xffff); vT[(e0 + 2 * q + 1) * 72 + sc_] = (bf16_t)(wa >> 16);
                vT[(e0 + 8 + 2 * q) * 72 + sc_] = (bf16_t)(wb & 0xffff); vT[(e0 + 8 + 2 * q + 1) * 72 + sc_] = (bf16_t)(wb >> 16); }
        }
        __syncthreads();
        { const int cn = c < 31 ? c + 1 : 31; SCAN_PREFETCH(cn); }
#pragma unroll
        for (int st = 0; st < 4; ++st) {
            f32x4 aq = {0.f, 0.f, 0.f, 0.f}, ak = aq;
            const int s = st * 16 + qi;
#pragma unroll
            for (int ks = 0; ks < 4; ++ks) { const bf16x8 uf = *(const LAS bf16x8*)(ucS + s * 136 + ks * 32 + quad * 8);
                aq = __builtin_amdgcn_mfma_f32_16x16x32_bf16(wqf[ks], uf, aq, 0, 0, 0); ak = __builtin_amdgcn_mfma_f32_16x16x32_bf16(wkf[ks], uf, ak, 0, 0, 0); }
            const int e = 16 * w + quad * 4;
            u32x2 qw; qw.x = pk2(aq[0], aq[1]); qw.y = pk2(aq[2], aq[3]); *(LAS u32x2*)(qS + s * 136 + e) = qw;
            u32x2 kw; kw.x = pk2(ak[0], ak[1]); kw.y = pk2(ak[2], ak[3]); *(LAS u32x2*)(kS + s * 136 + e) = kw;
            const float wsv = wS[s];
#pragma unroll
            for (int j = 0; j < 4; ++j) kwT[(e + j) * 72 + s] = (bf16_t)f2bf(ak[j] * wsv);
        }
        __syncthreads();
        {
            const int tt = w >> 1; const int t = tt * 16 + qi; const float Mt = MS[t];
#pragma unroll
            for (int si = 0; si < 2; ++si) { const int st = (w & 1) * 2 + si; const int srow = st * 16 + qi;
                f32x4 sa = {0.f, 0.f, 0.f, 0.f};
#pragma unroll
                for (int ks = 0; ks < 4; ++ks) { const bf16x8 kf = *(const LAS bf16x8*)(kS + srow * 136 + ks * 32 + quad * 8); const bf16x8 qf = *(const LAS bf16x8*)(qS + t * 136 + ks * 32 + quad * 8);
                    sa = __builtin_amdgcn_mfma_f32_16x16x32_bf16(kf, qf, sa, 0, 0, 0); }
                float pv[4];
#pragma unroll
                for (int j = 0; j < 4; ++j) { const int s = st * 16 + quad * 4 + j; pv[j] = (s <= t) ? sa[j] * __expf(cS[s] - Mt) : 0.f; }
                u32x2 pw; pw.x = pk2(pv[0], pv[1]); pw.y = pk2(pv[2], pv[3]); *(LAS u32x2*)(pS + t * 72 + st * 16 + quad * 4) = pw; }
        }
        __syncthreads();
        {
            const int tt = w >> 1; const int t = tt * 16 + qi; const float at = aS[t];
            const int ct0 = (w & 1) ? 5 : 0; const int nct = (w & 1) ? 4 : 5;
            f32x4 na[5];
#pragma unroll
            for (int ci = 0; ci < 5; ++ci) { na[ci] = (f32x4){0.f, 0.f, 0.f, 0.f};
                if (ci < nct) { const int ep = (ct0 + ci) * 16 + qi;
#pragma unroll
                    for (int ks = 0; ks < 4; ++ks) { const bf16x8 cf = *(const LAS bf16x8*)(CbT + ep * 136 + ks * 32 + quad * 8); const bf16x8 qf = *(const LAS bf16x8*)(qS + t * 136 + ks * 32 + quad * 8);
                        na[ci] = __builtin_amdgcn_mfma_f32_16x16x32_bf16(cf, qf, na[ci], 0, 0, 0); }
                    na[ci] = na[ci] * at;
#pragma unroll
                    for (int ks = 0; ks < 2; ++ks) { const bf16x8 vf = *(const LAS bf16x8*)(vT + ep * 72 + ((ks * 32 + quad * 8 + 8 * (ep >> 4)) & 63)); const bf16x8 pf = *(const LAS bf16x8*)(pS + t * 72 + ks * 32 + quad * 8);
                        na[ci] = __builtin_amdgcn_mfma_f32_16x16x32_bf16(vf, pf, na[ci], 0, 0, 0); } } }
            if ((w & 1) && quad == 0) denS[t] = na[3][0];
            __syncthreads();
            const float den = denS[t]; const float dn = fmaxf(fabsf(den), eS[t]); const float inv = 1.0f / dn;
            const int pos = dir ? t0 + 63 - t : t0 + t; const size_t tok = (size_t)b * SEQ + pos;
#pragma unroll
            for (int ci = 0; ci < 5; ++ci) { const int ct = ct0 + ci;
                if (ci < nct && ct < 8) { u32x2 hw; hw.x = pk2(na[ci][0] * inv, na[ci][1] * inv); hw.y = pk2(na[ci][2] * inv, na[ci][3] * inv);
                    *(u32x2*)(HB + tok * 512 + h * 128 + ct * 16 + quad * 4) = hw; } }
        }
        {
            const float decay = misc[0];
            const int drow = 16 * w + qi;
            bf16x8 kf[2];
#pragma unroll
            for (int ks = 0; ks < 2; ++ks) kf[ks] = *(const LAS bf16x8*)(kwT + drow * 72 + ks * 32 + quad * 8);
#pragma unroll
            for (int ct = 0; ct < NCT; ++ct) { C[ct] = C[ct] * decay;
#pragma unroll
                for (int ks = 0; ks < 2; ++ks) { const bf16x8 vf = *(const LAS bf16x8*)(vT + (ct * 16 + qi) * 72 + ((ks * 32 + quad * 8 + 8 * ct) & 63));
                    C[ct] = __builtin_amdgcn_mfma_f32_16x16x32_bf16(kf[ks], vf, C[ct], 0, 0, 0); }
                u32x2 cw; cw.x = pk2(C[ct][0], C[ct][1]); cw.y = pk2(C[ct][2], C[ct][3]);
                *(LAS u32x2*)(CbT + (ct * 16 + qi) * 136 + 16 * w + quad * 4) = cw; }
        }
        __syncthreads();
    }
}

__device__ __forceinline__ int iclamp(int v, int lo, int hi) { return v < lo ? lo : (v > hi ? hi : v); }
__device__ __forceinline__ void attn_step(const bf16x8 (&kf)[2][2], const bf16x8 (&vf)[4], const bf16x8 (&qf)[2], f32x4 (&o)[4], float& mrun, float& lrun,
                                          int k0, int M, int mq, int quad) {
    f32x4 sa[2];
#pragma unroll
    for (int T = 0; T < 2; ++T) { sa[T] = (f32x4){0.f, 0.f, 0.f, 0.f};
        sa[T] = __builtin_amdgcn_mfma_f32_16x16x32_bf16(kf[T][0], qf[0], sa[T], 0, 0, 0);
        sa[T] = __builtin_amdgcn_mfma_f32_16x16x32_bf16(kf[T][1], qf[1], sa[T], 0, 0, 0); }
    float sc[8]; float mx = -1e30f;
#pragma unroll
    for (int T = 0; T < 2; ++T)
#pragma unroll
        for (int jj = 0; jj < 4; ++jj) { const int kk = k0 + 8 * quad + 4 * T + jj; const int dq = kk - mq;
            const bool valid = (kk >= 0) && (kk < M) && (dq >= -64) && (dq <= 64);
            const float sv = valid ? sa[T][jj] : -1e30f; sc[T * 4 + jj] = sv; mx = fmaxf(mx, sv); }
    mx = fmaxf(mx, __shfl_xor(mx, 16)); mx = fmaxf(mx, __shfl_xor(mx, 32));
    const float mnew = fmaxf(mrun, mx); const float scale = __expf(mrun - mnew); mrun = mnew;
    float ps[8]; float lsum = 0.f;
#pragma unroll
    for (int i = 0; i < 8; ++i) { ps[i] = __expf(sc[i] - mnew); lsum += ps[i]; }
    lrun = lrun * scale + lsum;
    const u32x4 pwv = {pk2(ps[0], ps[1]), pk2(ps[2], ps[3]), pk2(ps[4], ps[5]), pk2(ps[6], ps[7])};
    const bf16x8 pf = __builtin_bit_cast(bf16x8, pwv);
#pragma unroll
    for (int dt = 0; dt < 4; ++dt) { o[dt] = o[dt] * scale; o[dt] = __builtin_amdgcn_mfma_f32_16x16x32_bf16(vf[dt], pf, o[dt], 0, 0, 0); }
}

constexpr int AT_KS = 0, AT_VS = 55296;
__device__ __forceinline__ void attn_unit(const Params& P, LAS unsigned char* lds, int b, int h, int blk, int tid) {
    const int lane = tid & 63, wave = tid >> 6, qi = lane & 15, quad = lane >> 4;
    const int krow = 8 * (qi >> 2) + (qi & 3);
    unsigned char* ws = P.ws;
    const bf16_t* ZB = (const bf16_t*)(ws + WS_ZB);
    bf16_t* MIX = (bf16_t*)(ws + WS_MIX);
    const int s0 = blk * 256;
    const size_t hb = (size_t)((b * 8 + h) * 64) * SEQ;
    LAS bf16_t* Ks = (LAS bf16_t*)(lds + AT_KS); LAS bf16_t* Vs = (LAS bf16_t*)(lds + AT_VS);
    __syncthreads();
    {
        int tl = tid; asm volatile("" : "+v"(tl));
#pragma unroll
        for (int i = 0; i < 6; ++i) { const int c = tl + 512 * i; const int row = c >> 3, ch = c & 7; const int pos = s0 - 64 + row;
            u32x4 kv = {0u, 0u, 0u, 0u}, vv = kv;
            if (pos >= 0 && pos < SEQ) { const bf16_t* zp = ZB + ((size_t)b * SEQ + pos) * ZW + h * 64 + ch * 8; kv = *(const u32x4*)(zp + 512); vv = *(const u32x4*)(zp + 1024); }
            *(LAS u32x4*)(Ks + row * 72 + ch * 8) = kv;
            const int colw = row + 8 * ch; LAS bf16_t* vd = Vs + (ch * 8) * 392 + (colw >= 384 ? colw - 384 : colw);
            vd[0 * 392] = (bf16_t)(vv.x & 0xffff); vd[1 * 392] = (bf16_t)(vv.x >> 16); vd[2 * 392] = (bf16_t)(vv.y & 0xffff); vd[3 * 392] = (bf16_t)(vv.y >> 16);
            vd[4 * 392] = (bf16_t)(vv.z & 0xffff); vd[5 * 392] = (bf16_t)(vv.z >> 16); vd[6 * 392] = (bf16_t)(vv.w & 0xffff); vd[7 * 392] = (bf16_t)(vv.w >> 16); }
    }
    int jj2[2], posq[2]; size_t tokq[2];
    bf16x8 qf[2][2]; f32x4 o[2][4]; float mrun[2], lrun[2];
#pragma unroll
    for (int t = 0; t < 2; ++t) { jj2[t] = 4 * (wave >> 1) + (wave & 1) + 2 * t;     posq[t] = s0 + jj2[t] + 16 * qi; tokq[t] = (size_t)b * SEQ + posq[t];
#pragma unroll
        for (int ks = 0; ks < 2; ++ks) qf[t][ks] = *(const bf16x8*)(ZB + tokq[t] * ZW + h * 64 + ks * 32 + quad * 8);
#pragma unroll
        for (int dt = 0; dt < 4; ++dt) o[t][dt] = (f32x4){0.f, 0.f, 0.f, 0.f};
        mrun[t] = -1e30f; lrun[t] = 0.f; }
    const bf16_t* Kb = ZB + (size_t)b * SEQ * ZW + 512 + h * 64 + quad * 8;
    {
        const int dil = 16, M = 128; int r[2], mq[2]; const bf16_t* VT[2];
#pragma unroll
        for (int t = 0; t < 2; ++t) { r[t] = jj2[t]; mq[t] = blk * 16 + qi; VT[t] = (const bf16_t*)(ws + WS_VT16) + hb + r[t] * 128; }
#pragma unroll 1
        for (int st = 0; st < 2; ++st) {
            const int k0 = st * 64;
#pragma unroll
            for (int t = 0; t < 2; ++t) {
                bf16x8 kf[2][2][2], vf[2][4];
#pragma unroll
                for (int hs = 0; hs < 2; ++hs) {
#pragma unroll
                    for (int T = 0; T < 2; ++T) { const int kc = iclamp(k0 + 32 * hs + krow + 4 * T, 0, M - 1); const bf16_t* kp = Kb + (size_t)(r[t] + dil * kc) * ZW;
                        kf[hs][T][0] = *(const bf16x8*)kp; kf[hs][T][1] = *(const bf16x8*)(kp + 32); }
                    const int g = iclamp(k0 + 32 * hs + 8 * quad, 0, M - 8);
#pragma unroll
                    for (int dt = 0; dt < 4; ++dt) vf[hs][dt] = *(const bf16x8*)(VT[t] + (size_t)(dt * 16 + qi) * SEQ + g);
                }
#pragma unroll
                for (int hs = 0; hs < 2; ++hs) attn_step(kf[hs], vf[hs], qf[t], o[t], mrun[t], lrun[t], k0 + 32 * hs, M, mq[t], quad);
                __builtin_amdgcn_sched_barrier(0);
            }
        }
    }
    __syncthreads();
#pragma unroll 1
    for (int st = 0; st < 12; ++st) {
        const int kl = st * 32, k0 = s0 - 64 + kl;
        bf16x8 kf[2][2], vf[4];
#pragma unroll
        for (int T = 0; T < 2; ++T)
#pragma unroll
            for (int ks = 0; ks < 2; ++ks) kf[T][ks] = *(const LAS bf16x8*)(Ks + (kl + krow + 4 * T) * 72 + ks * 32 + quad * 8);
#pragma unroll
        for (int dt = 0; dt < 4; ++dt) { const int colr = kl + 8 * quad + 8 * (2 * dt + (qi >> 3)); vf[dt] = *(const LAS bf16x8*)(Vs + (dt * 16 + qi) * 392 + (colr >= 384 ? colr - 384 : colr)); }
#pragma unroll
        for (int t = 0; t < 2; ++t) attn_step(kf, vf, qf[t], o[t], mrun[t], lrun[t], k0, SEQ, posq[t], quad);
    }
    {
        LAS bf16_t* K4s = (LAS bf16_t*)(lds + AT_KS); LAS bf16_t* V4s = (LAS bf16_t*)(lds + AT_VS);
        const int m0 = blk * 64 - 64;
#pragma unroll
        for (int p = 0; p < 2; ++p) {
            __syncthreads();
            int tl = tid; asm volatile("" : "+v"(tl));
#pragma unroll
            for (int i = 0; i < 6; ++i) { const int c = tl + 512 * i; const int cl = c >= 1536 ? 1 : 0; const int rem = c - cl * 1536;
                const int row = rem >> 3, ch = rem & 7; const int m = m0 + row;
                u32x4 kv = {0u, 0u, 0u, 0u}, vv = kv;
                if (m >= 0 && m < 512) { const bf16_t* zp = ZB + ((size_t)b * SEQ + 4 * m + 2 * p + cl) * ZW + h * 64 + ch * 8; kv = *(const u32x4*)(zp + 512); vv = *(const u32x4*)(zp + 1024); }
                *(LAS u32x4*)(K4s + (cl * 192 + row) * 72 + ch * 8) = kv;
                const int colw = row + 8 * ch; LAS bf16_t* vd = V4s + (cl * 64 + ch * 8) * 200 + (colw >= 192 ? colw - 192 : colw);
                vd[0 * 200] = (bf16_t)(vv.x & 0xffff); vd[1 * 200] = (bf16_t)(vv.x >> 16); vd[2 * 200] = (bf16_t)(vv.y & 0xffff); vd[3 * 200] = (bf16_t)(vv.y >> 16);
                vd[4 * 200] = (bf16_t)(vv.z & 0xffff); vd[5 * 200] = (bf16_t)(vv.z >> 16); vd[6 * 200] = (bf16_t)(vv.w & 0xffff); vd[7 * 200] = (bf16_t)(vv.w >> 16); }
            __syncthreads();
            const int cl = (jj2[p] & 3) - 2 * p; const int mq = blk * 64 + (jj2[p] >> 2) + 4 * qi;
#pragma unroll 1
            for (int st = 0; st < 6; ++st) {
                const int kl = st * 32;
                bf16x8 kf[2][2], vf[4];
#pragma unroll
                for (int T = 0; T < 2; ++T)
#pragma unroll
                    for (int ks = 0; ks < 2; ++ks) kf[T][ks] = *(const LAS bf16x8*)(K4s + (cl * 192 + kl + krow + 4 * T) * 72 + ks * 32 + quad * 8);
#pragma unroll
                for (int dt = 0; dt < 4; ++dt) { const int colr = kl + 8 * quad + 8 * (2 * dt + (qi >> 3)); vf[dt] = *(const LAS bf16x8*)(V4s + (cl * 64 + dt * 16 + qi) * 200 + (colr >= 192 ? colr - 192 : colr)); }
                attn_step(kf, vf, qf[p], o[p], mrun[p], lrun[p], m0 + kl, 512, mq, quad);
            }
        }
    }
#pragma unroll
    for (int t = 0; t < 2; ++t) {
        float l = lrun[t]; l += __shfl_xor(l, 16); l += __shfl_xor(l, 32);
        const float inv = 1.0f / l;
#pragma unroll
        for (int dt = 0; dt < 4; ++dt) { u32x2 w; w.x = pk2(o[t][dt][0] * inv, o[t][dt][1] * inv); w.y = pk2(o[t][dt][2] * inv, o[t][dt][3] * inv);
            *(u32x2*)(MIX + tokq[t] * DM + h * 64 + dt * 16 + quad * 4) = w; }
    }
}

__device__ __forceinline__ void mlstm_post_row(const Params& P, int tok, int lane) {
    unsigned char* ws = P.ws;
    const bf16_t* HF = (const bf16_t*)P.out; const bf16_t* HBk = (const bf16_t*)P.out + (size_t)MTOK * 512; const bf16_t* ZB = (const bf16_t*)(ws + WS_ZB); bf16_t* MIX = (bf16_t*)(ws + WS_MIX);
    const u32x4 a = __builtin_nontemporal_load((const u32x4*)(HF + (size_t)tok * 512 + lane * 8)), c = __builtin_nontemporal_load((const u32x4*)(HBk + (size_t)tok * 512 + lane * 8));
    float v[8];
#pragma unroll
    for (int q = 0; q < 4; ++q) { v[2 * q] = bflo(a[q]) + bflo(c[q]); v[2 * q + 1] = bfhi(a[q]) + bfhi(c[q]); }
    float s = 0.f;
#pragma unroll
    for (int i = 0; i < 8; ++i) s += v[i];
#pragma unroll
    for (int o = 1; o < 16; o <<= 1) s += __shfl_xor(s, o);
    const float mu = s * (1.0f / 128.0f); float q2 = 0.f;
#pragma unroll
    for (int i = 0; i < 8; ++i) { v[i] -= mu; q2 += v[i] * v[i]; }
#pragma unroll
    for (int o = 1; o < 16; o <<= 1) q2 += __shfl_xor(q2, o);
    const float rs = rsqrtf(q2 * (1.0f / 128.0f) + EPSF);
    const u32x4 og = __builtin_nontemporal_load((const u32x4*)(ZB + (size_t)tok * ZW + 2560 + lane * 8));
    const f32x4 g0 = *(const f32x4*)(P.gn_g + lane * 8), g1 = *(const f32x4*)(P.gn_g + lane * 8 + 4);
    float y[8];
#pragma unroll
    for (int q = 0; q < 4; ++q) { const float o0 = bflo(og[q]), o1 = bfhi(og[q]); const float gg0 = q < 2 ? g0[2 * q] : g1[2 * q - 4], gg1 = q < 2 ? g0[2 * q + 1] : g1[2 * q - 3];
        y[2 * q] = v[2 * q] * rs * gg0 * sigmoidf_(o0); y[2 * q + 1] = v[2 * q + 1] * rs * gg1 * sigmoidf_(o1); }
    u32x4 w; w.x = pk2(y[0], y[1]); w.y = pk2(y[2], y[3]); w.z = pk2(y[4], y[5]); w.w = pk2(y[6], y[7]);
    *(u32x4*)(MIX + (size_t)tok * DM + 512 + lane * 8) = w;
}


#define XB_TMO      128
#define XB_XCNT(j)  (256  + 64 * (j))
#define XB_XSUB(j)  (1280 + 64 * (j))
#define XB_XGEN(j)  (2304 + 64 * (j))
#define XB_TOP      3328
#define XB_TOPGEN   3392
#define XCD_BAR_WORDS 3456
#define XB_SPIN_CAP (1u << 20)
__device__ __forceinline__ unsigned xb_ld(unsigned* p)              { return __hip_atomic_load(p, __ATOMIC_RELAXED, __HIP_MEMORY_SCOPE_AGENT); }
__device__ __forceinline__ unsigned xb_add(unsigned* p, unsigned v) { return __hip_atomic_fetch_add(p, v, __ATOMIC_RELAXED, __HIP_MEMORY_SCOPE_AGENT); }
__device__ __forceinline__ unsigned xb_xcc_id() { return (unsigned)__builtin_amdgcn_s_getreg((3 << 11) | 20) & 0xFu; }
#define XB_SPIN(cond, bar) do { unsigned _sp = 0; while (cond) { __builtin_amdgcn_s_sleep(1); \
    if ((++_sp & 255u) == 0u) { if (xb_ld(&(bar)[XB_TMO])) break; if (_sp > XB_SPIN_CAP) { atomicAdd(&(bar)[XB_TMO], 1u); break; } } } } while (0)
struct XcdBarrier { unsigned* bar; unsigned x; volatile LAS unsigned* st; };
__device__ __forceinline__ XcdBarrier xcd_barrier_post(unsigned* bar, volatile LAS unsigned* st) {
    XcdBarrier b; b.bar = bar; b.x = xb_xcc_id(); b.st = st;
    if (threadIdx.x == 0) (void)xb_add(&bar[XB_XCNT(b.x)], 1u);
    return b;
}
__device__ __forceinline__ void xcd_barrier_complete(unsigned* bar, unsigned x, unsigned& nloc, unsigned& nx) {
    const unsigned G = gridDim.x * gridDim.y * gridDim.z;
    unsigned sum, cnt, mine, sp = 0u;
    for (;;) {
        sum = 0u; cnt = 0u; mine = 0u;
#pragma unroll
        for (unsigned j = 0; j < 16; ++j) { const unsigned c = xb_ld(&bar[XB_XCNT(j)]); sum += c; cnt += (c > 0u) ? 1u : 0u; mine = (j == x) ? c : mine; }
        if (sum == G) break;
        __builtin_amdgcn_s_sleep(1);
        if ((++sp & 255u) == 0u) { if (xb_ld(&bar[XB_TMO])) break; if (sp > XB_SPIN_CAP) { atomicAdd(&bar[XB_TMO], 1u); break; } }
    }
    nloc = mine > 0u ? mine : 1u; nx = cnt > 0u ? cnt : 1u;
}
__device__ __forceinline__ void xcd_barrier(const XcdBarrier& b) {
    asm volatile("s_waitcnt vmcnt(0)" ::: "memory");
    __syncthreads();
    if (threadIdx.x == 0) {
        unsigned* bar = b.bar;
        __builtin_amdgcn_s_waitcnt(0);
        unsigned nloc = b.st[0], nx = b.st[1];
        if (nloc == 0u) { xcd_barrier_complete(bar, b.x, nloc, nx); b.st[0] = nloc; b.st[1] = nx; }
        const unsigned old = xb_add(&bar[XB_XSUB(b.x)], 1u);
        const unsigned gen = old / nloc;
        if (old + 1u == (gen + 1u) * nloc) {
            __builtin_amdgcn_fence(__ATOMIC_RELEASE, "agent");
            asm volatile("s_waitcnt vmcnt(0)" ::: "memory");
            const unsigned og = xb_add(&bar[XB_TOP], 1u);
            const unsigned tg = og / nx;
            if (og + 1u == (tg + 1u) * nx) xb_add(&bar[XB_TOPGEN], 1u);
            else XB_SPIN(xb_ld(&bar[XB_TOPGEN]) == tg, bar);
            __builtin_amdgcn_fence(__ATOMIC_ACQUIRE, "agent");
            xb_add(&bar[XB_XGEN(b.x)], 1u);
            asm volatile("s_waitcnt vmcnt(0)" ::: "memory");
        } else {
            XB_SPIN(xb_ld(&bar[XB_XGEN(b.x)]) == gen, bar);
            __builtin_amdgcn_fence(__ATOMIC_ACQUIRE, "agent");
            asm volatile("s_waitcnt vmcnt(0)" ::: "memory");
        }
    }
    __syncthreads();
}
#define GRID_SYNC() xcd_barrier(xbar)
__global__ void __launch_bounds__(512) fwd_megakernel(Params P) {
    extern __shared__ __attribute__((aligned(16))) unsigned char lds_raw[];
    LAS unsigned char* lds = (LAS unsigned char*)lds_raw;
    cg::grid_group grid = cg::this_grid();
    const int G = gridDim.x, bid = blockIdx.x;
    unsigned char* ws = P.ws;
    if (G == 0x7fffffff) grid.sync();
    { volatile LAS unsigned* stw = (volatile LAS unsigned*)(lds + LDS_ST_OFF); if (threadIdx.x < 4) stw[threadIdx.x] = 0u; }
    __syncthreads();
    const XcdBarrier xbar = xcd_barrier_post((unsigned*)(ws + WS_BAR), (volatile LAS unsigned*)(lds + LDS_ST_OFF));

    for (int rep = 0; rep < REP_MISC; ++rep) phase_prologue(P, lds, G);
    GRID_SYNC();
    {
        pg8::Gemm g{(const bf16_t*)(ws + WS_XB), (const bf16_t*)(ws + WS_WIN), MTOK, NZPAD, DM}; pg8::StaticOrder S; S.init(MTOK, NZPAD, G, bid);
        pg8::EpiZ E{(bf16_t*)(ws + WS_ZB), (float*)(ws + WS_GATES), (const float*)(ws + WS_R0), (const float*)(ws + WS_CS), (bf16_t*)(ws + WS_VT16)};
        for (int rep = 0; rep < REP_G; ++rep) pg8::gemm_phase<pg8::EpiZ, true>(lds, g, S, E);
    }
    GRID_SYNC();
#ifdef PROBE_STOP
    if (PROBE_STOP == 1) {
        int tid = threadIdx.x; asm volatile("" : "+v"(tid));
        for (size_t i = (size_t)bid * 512 + tid; i < (size_t)MTOK * DM; i += (size_t)G * 512) {
            const size_t m = i >> 10, c = i & 1023; float v;
            if (PROBE_STOP == 1) { const bf16_t* ZBp = (const bf16_t*)(ws + WS_ZB); v = bf1(ZBp[m * ZW + c]) + bf1(ZBp[m * ZW + c + 1024]) + bf1(ZBp[m * ZW + c + 2048]) + ((const float*)(ws + WS_GATES))[m * 16 + (c & 15)]; }
            else if (PROBE_STOP == 2) { v =
#ifndef PROBE_NOSCAN
 bf1(((const bf16_t*)(ws + WS_HF))[m * 512 + (c & 511)]) + bf1(((const bf16_t*)(ws + WS_HB))[m * 512 + (c & 511)]) +
#endif
 bf1(((const bf16_t*)(ws + WS_VT1))[i]) + bf1(((const bf16_t*)(ws + WS_VT4))[i]) + bf1(((const bf16_t*)(ws + WS_VT16))[i]); }
            else { v = bf1(((const bf16_t*)(ws + WS_MIX))[i]); }
            if (!(fabsf(v) < 1e30f)) v = 12345.f;
            P.out[i] = v; }
        return;
    }
#endif
    {
        int tid = threadIdx.x; asm volatile("" : "+v"(tid));
        const int nscan = G >= 256 ? 128 : (G > 1 ? G / 2 : 1);
        if (bid < nscan) for (int it = bid; it < 128; it += nscan) scan_item(P, lds, it);
        unsigned* queue = (unsigned*)(ws + WS_BAR) + 3520;
        volatile LAS unsigned* qw = (volatile LAS unsigned*)(lds + LDS_ST_OFF + 16);
        for (;;) {
            __syncthreads();
            if (tid == 0) qw[0] = __hip_atomic_fetch_add(queue, 1u, __ATOMIC_RELAXED, __HIP_MEMORY_SCOPE_AGENT);
            __syncthreads();
            const int u = (int)qw[0];
            if (u >= NB * 8 * 8) break;
            attn_unit(P, lds, u >> 6, (u >> 3) & 7, u & 7, tid);
        }
    }
    GRID_SYNC();
    {
        int tid = threadIdx.x; asm volatile("" : "+v"(tid));
        const int lane = tid & 63, wave = tid >> 6;
        for (int tok = bid * 8 + wave; tok < MTOK; tok += G * 8) mlstm_post_row(P, tok, lane);
    }
    GRID_SYNC();
    {
        pg8::Gemm g{(const bf16_t*)(ws + WS_MIX), (const bf16_t*)(ws + WS_WOUT), MTOK, DM, DM}; pg8::StaticOrder S; S.init(MTOK, DM, G, bid);
        pg8::EpiRes<true> E{nullptr, (bf16_t*)(ws + WS_XB), (float*)(ws + WS_SS1)};
        pg8::gemm_phase<pg8::EpiRes<true>, true>(lds, g, S, E);
    }
    GRID_SYNC();
    {
        pg8::Gemm g{(const bf16_t*)(ws + WS_XB), (const bf16_t*)(ws + WS_WG), MTOK, NGU, DM}; pg8::StaticOrder S; S.init(MTOK, NGU, G, bid);
        pg8::EpiGU E{(bf16_t*)(ws + WS_ACT), (const float*)(ws + WS_SS1), P.fconv_w, P.fconv_b, (float*)(ws + WS_HALO), (LAS float*)(lds + 131072)};
        pg8::gemm_phase<pg8::EpiGU, true>(lds, g, S, E);
    }
    GRID_SYNC();
    {
        int tid = threadIdx.x; asm volatile("" : "+v"(tid));
        const float* HALO = (const float*)(ws + WS_HALO); bf16_t* ACT = (bf16_t*)(ws + WS_ACT);
        for (int idx = bid * 512 + tid; idx < (MTOK / 256) * 2 * FF; idx += G * 512) {
            const int col = idx % FF; const int pe_ = idx / FF; const int e = pe_ & 1, pm = pe_ >> 1;
            const float* H = HALO + (size_t)((pm * 2 + e) * 3) * FF;
            float a = H[FF + col]; const float uu = H[2 * FF + col];
            if (e == 0) { if ((pm & 7) != 0) a += HALO[(size_t)(((pm - 1) * 2 + 1) * 3) * FF + col] * P.fconv_w[col]; }
            else        { if ((pm & 7) != 7) a += HALO[(size_t)(((pm + 1) * 2 + 0) * 3) * FF + col] * P.fconv_w[2 * FF + col]; }
            const int row = pm * 256 + (e ? 255 : 0);
            ACT[(size_t)row * FF + col] = (bf16_t)f2bf(gelu1(a) * uu);
        }
    }
    GRID_SYNC();
    {
        pg8::Gemm g{(const bf16_t*)(ws + WS_ACT), (const bf16_t*)(ws + WS_WD), MTOK, DM, FF}; pg8::StaticOrder S; S.init(MTOK, DM, G, bid);
        pg8::EpiRes<true> E{nullptr, (bf16_t*)(ws + WS_XB), (float*)(ws + WS_SS2)};
        pg8::gemm_phase<pg8::EpiRes<true>, true>(lds, g, S, E);
    }
    GRID_SYNC();
    {
        pg8::Gemm g{(const bf16_t*)(ws + WS_XB), (const bf16_t*)(ws + WS_WPG), MTOK, DM, DM}; pg8::StaticOrder S; S.init(MTOK, DM, G, bid);
        {
            int kpp = 256; asm volatile("" : "+s"(kpp));
            pg8::Gemm g2{(const bf16_t*)(ws + WS_PB), (const bf16_t*)(ws + WS_WPP), MTOK, DM, kpp}; pg8::StaticOrder S2; S2.init(MTOK, DM, G, bid);
            pg8::EpiStore E2{(bf16_t*)P.out};
            pg8::gemm_phase<pg8::EpiStore, true>(lds, g2, S2, E2);
            asm volatile("s_waitcnt vmcnt(0)" ::: "memory"); __syncthreads();
        }
        pg8::EpiSigPle E{(bf16_t*)(ws + WS_XB), (const bf16_t*)P.out, (const float*)(ws + WS_SS2), P.b_pg, (float*)(ws + WS_SS3)};
        pg8::gemm_phase<pg8::EpiSigPle, true>(lds, g, S, E);
    }
    GRID_SYNC();
    for (int rep = 0; rep < REP_SYNC; ++rep) GRID_SYNC();
    {
        int tid = threadIdx.x; asm volatile("" : "+v"(tid));
        const int lane = tid & 63, wave = tid >> 6;
        const float* ss3 = (const float*)(ws + WS_SS3);
        f32x4 gv[4];
#pragma unroll
        for (int j = 0; j < 4; ++j) gv[j] = *((const f32x4*)P.ln_f_g + lane + 64 * j);
        const int NW = G * 8;
        for (int m0 = bid * 8 + wave; m0 < MTOK; m0 += 2 * NW) {
            const int m1 = (m0 + NW < MTOK) ? m0 + NW : m0;
            u32x2 xv[2][4]; float sv[2];
#pragma unroll
            for (int q = 0; q < 2; ++q) { const int m = q ? m1 : m0; sv[q] = ss3[m]; const u32x2* xr = (const u32x2*)((const bf16_t*)(ws + WS_XB) + (size_t)m * DM) + lane;
#pragma unroll
                for (int j = 0; j < 4; ++j) xv[q][j] = __builtin_nontemporal_load(xr + 64 * j); }
#pragma unroll
            for (int q = 0; q < 2; ++q) { const int m = q ? m1 : m0;
                if (q == 1 && m1 == m0) break;
                const float r = rsqrtf(sv[q] * (1.0f / DM) + EPSF);
                f32x4* orow = (f32x4*)(P.out + (size_t)m * DM) + lane;
#pragma unroll
                for (int j = 0; j < 4; ++j) { const f32x4 v = {bflo(xv[q][j].x), bfhi(xv[q][j].x), bflo(xv[q][j].y), bfhi(xv[q][j].y)}; __builtin_nontemporal_store(v * r * gv[j], orow + 64 * j); } }
        }
    }
}

extern "C" void kernel_launch(void* const* d_in, const int* in_sizes, int n_in, void* d_out, int out_size, void* d_ws, size_t ws_size, hipStream_t stream) {
    static int grid_blocks = 0;
    if (grid_blocks == 0) {
        if (n_in != 24 || ws_size < WS_NEED) { fprintf(stderr, "kernel_launch: unexpected n_in %d / ws %zu\n", n_in, ws_size); grid_blocks = -1; return; }
        int dev = 0, cus = 0, per_cu = 0;
        hipGetDevice(&dev);
        hipDeviceGetAttribute(&cus, hipDeviceAttributeMultiprocessorCount, dev);
        if (hipFuncSetAttribute((const void*)fwd_megakernel, hipFuncAttributeMaxDynamicSharedMemorySize, LDS_BYTES) != hipSuccess) { fprintf(stderr, "hipFuncSetAttribute failed\n"); grid_blocks = -1; return; }
        if (hipOccupancyMaxActiveBlocksPerMultiprocessor(&per_cu, (const void*)fwd_megakernel, 512, LDS_BYTES) != hipSuccess || per_cu < 1) { fprintf(stderr, "occupancy query failed (%d)\n", per_cu); per_cu = 1; }
        (void)hipGetLastError();
        grid_blocks = cus * 1;
        if (grid_blocks <= 0) grid_blocks = 256;
    }
    if (grid_blocks < 0) return;
    Params P{};
    P.x = (const float*)d_in[0]; P.p = (const float*)d_in[1]; P.pos = (const int*)d_in[2];
    P.ln_mix_g = (const float*)d_in[3]; P.w_in = (const float*)d_in[4]; P.mconv_w = (const float*)d_in[5]; P.mconv_b = (const float*)d_in[6];
    P.w_mq = (const float*)d_in[7]; P.w_mk = (const float*)d_in[8]; P.b_ig = (const float*)d_in[9]; P.b_fg = (const float*)d_in[10]; P.gn_g = (const float*)d_in[11];
    P.w_out = (const float*)d_in[12]; P.ln_ffn_g = (const float*)d_in[13]; P.w_fg = (const float*)d_in[14]; P.fconv_w = (const float*)d_in[15]; P.fconv_b = (const float*)d_in[16];
    P.w_fu = (const float*)d_in[17]; P.w_fd = (const float*)d_in[18]; P.ln_ple_g = (const float*)d_in[19]; P.w_pg = (const float*)d_in[20]; P.b_pg = (const float*)d_in[21];
    P.w_pp = (const float*)d_in[22]; P.ln_f_g = (const float*)d_in[23];
    P.out = (float*)d_out; P.ws = (unsigned char*)d_ws;
    for (int j = 0; j < 8; ++j) P.invrev[j] = std::pow(500000.0, -(double)j / 8.0) / 6.283185307179586476925;
    if (hipMemsetAsync((unsigned char*)d_ws + WS_BAR, 0, 16384, stream) != hipSuccess) { fprintf(stderr, "memset failed\n"); return; }
    void* args[] = {&P};
    hipError_t e = hipLaunchCooperativeKernel((const void*)fwd_megakernel, dim3(grid_blocks), dim3(512), args, LDS_BYTES, stream);
    if (e != hipSuccess) fprintf(stderr, "cooperative launch failed: %s (grid %d)\n", hipGetErrorString(e), grid_blocks);
}
```

```cpp
#ifndef REP_ATTN
#define REP_ATTN 1
#endif
#ifndef REP_G
#define REP_G 1
#endif
#ifndef REP_MISC
#define REP_MISC 1
#endif
#ifndef REP_SYNC
#define REP_SYNC 0
#endif
#ifndef REP_SCAN
#define REP_SCAN 1
#endif
#include <hip/hip_runtime.h>
#include <hip/hip_cooperative_groups.h>
#include <cstdio>
#include <cstdint>
#include <cmath>
namespace cg = cooperative_groups;

#define LAS __attribute__((address_space(3)))
typedef unsigned short bf16_t;
typedef short bf16x8 __attribute__((ext_vector_type(8)));
typedef short bf16x4 __attribute__((ext_vector_type(4)));
typedef float f32x4 __attribute__((ext_vector_type(4)));
typedef float f32x2 __attribute__((ext_vector_type(2)));
typedef unsigned u32x4 __attribute__((ext_vector_type(4)));
typedef unsigned u32x2 __attribute__((ext_vector_type(2)));

constexpr int NB = 16, SEQ = 2048, DM = 1024, MTOK = NB * SEQ;
constexpr int ZW = 3072;
constexpr int NZPAD = 3328;
constexpr int NIN = 3088;
constexpr int FF = 2816;
constexpr int NGU = 2 * FF;
constexpr float EPSF = 1e-6f;

constexpr size_t MiB = 1u << 20;
constexpr size_t WS_R0 = 0, WS_SS1 = 128 * 1024, WS_SS2 = 256 * 1024, WS_SS3 = 384 * 1024;
constexpr size_t WS_BAR = 512 * 1024;
constexpr size_t WS_CS = 1 * MiB, WS_GATES = 3 * MiB;
constexpr size_t WS_WIN = 5 * MiB, WS_WOUT = 12 * MiB, WS_WG = 14 * MiB, WS_WU = 20 * MiB, WS_WD = 26 * MiB, WS_WPG = 32 * MiB, WS_WPP = 34 * MiB;
constexpr size_t WS_PB = 36 * MiB;
constexpr size_t WS_XB = 52 * MiB, WS_HF = 52 * MiB, WS_HB = 84 * MiB;
constexpr size_t WS_ZB = 116 * MiB;
constexpr size_t WS_VT1 = 308 * MiB, WS_VT4 = 340 * MiB, WS_VT16 = 372 * MiB;
constexpr size_t WS_MIX = 404 * MiB;
constexpr size_t WS_GP = 116 * MiB, WS_ACT = 292 * MiB, WS_SG = 116 * MiB;
constexpr size_t WS_HALO = 470 * MiB;
constexpr size_t WS_NEED = 480 * MiB;

constexpr int LDS_BYTES = 147456;
constexpr int LDS_ST_OFF = 147392;

struct Params {
    const float* x; const float* p; const int* pos;
    const float* ln_mix_g; const float* w_in; const float* mconv_w; const float* mconv_b; const float* w_mq; const float* w_mk;
    const float* b_ig; const float* b_fg; const float* gn_g; const float* w_out; const float* ln_ffn_g; const float* w_fg; const float* fconv_w; const float* fconv_b;
    const float* w_fu; const float* w_fd; const float* ln_ple_g; const float* w_pg; const float* b_pg; const float* w_pp; const float* ln_f_g;
    float* out; unsigned char* ws;
    double invrev[8];
};

typedef __bf16 bf16x2v __attribute__((ext_vector_type(2)));
__device__ __forceinline__ unsigned f2bf(float f) { return (unsigned)__builtin_bit_cast(unsigned short, (__bf16)f); }
__device__ __forceinline__ unsigned pk2(float lo, float hi) { f32x2 v = {lo, hi}; bf16x2v b = __builtin_convertvector(v, bf16x2v); return __builtin_bit_cast(unsigned, b); }
__device__ __forceinline__ float bflo(unsigned w) { return __builtin_bit_cast(float, w << 16); }
__device__ __forceinline__ float bfhi(unsigned w) { return __builtin_bit_cast(float, w & 0xffff0000u); }
__device__ __forceinline__ float bf1(bf16_t h) { return __builtin_bit_cast(float, ((unsigned)h) << 16); }
__device__ __forceinline__ float wave_sum(float v) {
#pragma unroll
    for (int o = 1; o < 64; o <<= 1) v += __shfl_xor(v, o);
    return v;
}
__device__ __forceinline__ float sigmoidf_(float x) { return 1.0f / (1.0f + __expf(-x)); }
__device__ __forceinline__ float gelu1(float v) {
    const float av = fabsf(v), d = av * 0.2316418882f + 1.0f;
    const float t = __builtin_amdgcn_rcpf(d);
    float q = t * 0.5307027145f + (-0.7265760135f); q = q * t + 0.7107068705f; q = q * t + (-0.142248368f); q = q * t + 0.127414796f; q = q * t;
    const float e = __builtin_amdgcn_exp2f((v * v) * (-0.72134752044f));
    const float m = v * (q * e), r = v - m;
    return v < 0.f ? m : r;
}

namespace pg8 {
constexpr int BM = 256, BK = 64, HALF = 128, HTB = HALF * BK * 2, STAGE_BYTES = 8 * HTB, NXCD = 8, WGM = 8;
__host__ __device__ __forceinline__ int lds_byte(int r, int c) { const int st = (r >> 4) * 2 + (c >> 5), rr = r & 15, cc = c & 31, ob = rr * 64 + cc * 2; return st * 1024 + (ob ^ (((ob >> 9) & 1) << 5)); }
__host__ __device__ __forceinline__ void stage_rc(int b, int& R, int& C) { const int st = b / 1024, sb = b % 1024, swz = sb ^ (((sb >> 9) & 1) << 5); R = (st >> 1) * 16 + swz / 64; C = (st & 1) * 32 + (swz % 64) / 2; }
__host__ __device__ __forceinline__ int perm32(int rho) { const int n = rho >> 4, i = rho & 15; return 8 * (i >> 2) + 4 * n + (i & 3); }

struct Unit { int pm, pn; };
struct Gemm { const bf16_t* A; const bf16_t* Bt; int M, N, K; };

struct StaticOrder {
    int nM, nN, nwg, G, c;
    __device__ void init(int M, int N, int G_, int c_) { nM = M / BM; nN = N / BM; nwg = nM * nN; G = G_; c = c_; }
    __device__ bool next(int i, Unit& u) const {
        const long L = (long)i * G + c; if (L >= nwg) return false;
        int wgid = (int)L; { const int q = nwg / NXCD, r = nwg % NXCD, xcd = wgid % NXCD, off = wgid / NXCD; wgid = (xcd < r ? xcd * (q + 1) : r * (q + 1) + (xcd - r) * q) + off; }
        const int nig = WGM * nN, gid = wgid / nig, fm = gid * WGM, gsz = (nM - fm) < WGM ? (nM - fm) : WGM;
        u.pm = fm + ((wgid % nig) % gsz); u.pn = (wgid % nig) / gsz; return true;
    }
};

template <class Epi, bool ALIGN_EPI>
__device__ __forceinline__ void gemm_phase(LAS unsigned char* lds, const Gemm g, const StaticOrder& S, const Epi& E) {
    int tid = threadIdx.x; asm volatile("" : "+v"(tid));
    const int wid = __builtin_amdgcn_readfirstlane(tid >> 6), lane = tid & 63, wr = wid >> 2, wc = wid & 3, fr = lane & 15, fq = lane >> 4;
    const int K = g.K, nt = K / BK;
    unsigned voffA[2], voffB[2];
#pragma unroll
    for (int i = 0; i < 2; ++i) { int R, C; stage_rc(tid * 16 + i * 8192, R, C); const int Rb = Epi::PERM ? ((R & ~31) + perm32(R & 31)) : R;
        voffA[i] = (unsigned)(R * K + C) * 2u; voffB[i] = (unsigned)(Rb * K + C) * 2u; }
    const size_t kstep = (size_t)(BK * 2);
    const size_t hstep = (size_t)HALF * K * 2;
    const size_t tstep = 2 * hstep;
    const unsigned ldsw = (unsigned)wid * 1024u;
    const int aoff = lds_byte(wr * 64 + fr, fq * 8), boff = lds_byte(wc * 32 + fr, fq * 8);
#define PG8_SA(b, h) (((b) * 2 + (h)) * HTB)
#define PG8_SB(b, h) ((4 + (b) * 2 + (h)) * HTB)
#define PG8_STAGE(bufoff, gbase, voff) do { _Pragma("unroll") for (int _i = 0; _i < 2; ++_i) \
        __builtin_amdgcn_global_load_lds((const unsigned*)((const char*)(gbase) + (voff)[_i]), (LAS unsigned*)(lds + (bufoff) + ldsw + _i * 8192), 16, 0, 0); } while (0)
#define PG8_LDA(dst, b, h) do { _Pragma("unroll") for (int m = 0; m < 4; ++m) _Pragma("unroll") for (int k = 0; k < 2; ++k) dst[m][k] = *(const LAS bf16x8*)(lds + PG8_SA(b, h) + aoff + m * 2048 + k * 1024); } while (0)
#define PG8_LDB(dst, b, h) do { _Pragma("unroll") for (int n = 0; n < 2; ++n) _Pragma("unroll") for (int k = 0; k < 2; ++k) dst[n][k] = *(const LAS bf16x8*)(lds + PG8_SB(b, h) + boff + n * 2048 + k * 1024); } while (0)
#define PG8_MMA(ai, bj, At, Bt) do { __builtin_amdgcn_s_setprio(1); _Pragma("unroll") for (int m = 0; m < 4; ++m) _Pragma("unroll") for (int n = 0; n < 2; ++n) _Pragma("unroll") for (int k = 0; k < 2; ++k) \
        acc[ai][bj][m][n] = __builtin_amdgcn_mfma_f32_16x16x32_bf16(Bt[n][k], At[m][k], acc[ai][bj][m][n], 0, 0, 0); __builtin_amdgcn_s_setprio(0); } while (0)
#define PG8_WAIT_V(n) asm volatile("s_waitcnt vmcnt(" #n ")" ::: "memory")
#define PG8_WAIT_L(n) asm volatile("s_waitcnt lgkmcnt(" #n ")" ::: "memory")
#define PG8_BAR __builtin_amdgcn_s_barrier()
#define PG8_SCHED __builtin_amdgcn_sched_barrier(0)
    Unit cur, nxt; int ui = 0;
    if (!S.next(0, cur)) return;
    f32x4 acc[2][2][4][2];
#pragma unroll
    for (int a = 0; a < 2; ++a)
#pragma unroll
        for (int b = 0; b < 2; ++b)
#pragma unroll
            for (int m = 0; m < 4; ++m)
#pragma unroll
                for (int n = 0; n < 2; ++n) acc[a][b][m][n] = (f32x4){0.f, 0.f, 0.f, 0.f};
    bf16x8 At[4][2], B0[2][2], B1[2][2];
    const char* cA = (const char*)g.A + (size_t)cur.pm * tstep; const char* cB = (const char*)g.Bt + (size_t)cur.pn * tstep;
    PG8_STAGE(PG8_SB(0, 0), cB, voffB); PG8_STAGE(PG8_SB(0, 1), cB + hstep, voffB); PG8_STAGE(PG8_SA(0, 0), cA, voffA); PG8_STAGE(PG8_SA(0, 1), cA + hstep, voffA);
    if (wr == 1) PG8_BAR;
    PG8_WAIT_V(2); PG8_BAR;
    PG8_STAGE(PG8_SB(1, 0), cB + kstep, voffB); PG8_STAGE(PG8_SA(1, 0), cA + kstep, voffA); PG8_STAGE(PG8_SB(1, 1), cB + hstep + kstep, voffB);
    PG8_WAIT_V(6); PG8_BAR;
    for (;;) {
        const bool has_next = S.next(ui + 1, nxt);
        const char* nA = has_next ? (const char*)g.A + (size_t)nxt.pm * tstep : cA; const char* nB = has_next ? (const char*)g.Bt + (size_t)nxt.pn * tstep : cB;
        for (int t = 0; t < nt; t += 2) {
            const bool last = (t == nt - 2);
            const char* a1 = cA + (size_t)(t + 1) * kstep;
            const char* a2 = last ? nA : cA + (size_t)(t + 2) * kstep; const char* b2 = last ? nB : cB + (size_t)(t + 2) * kstep;
            const char* a3 = a2 + kstep; const char* b3 = b2 + kstep;
            PG8_LDB(B0, 0, 0); PG8_LDB(B1, 0, 1); PG8_SCHED; PG8_LDA(At, 0, 0); PG8_STAGE(PG8_SA(1, 1), a1 + hstep, voffA);
            PG8_WAIT_V(8); PG8_WAIT_L(0); PG8_BAR; PG8_MMA(0, 0, At, B0); PG8_MMA(0, 1, At, B1); PG8_BAR; PG8_SCHED;
            PG8_LDA(At, 0, 1); PG8_STAGE(PG8_SB(0, 0), b2, voffB); PG8_STAGE(PG8_SB(0, 1), b2 + hstep, voffB); PG8_STAGE(PG8_SA(0, 0), a2, voffA);
            PG8_WAIT_V(8); PG8_WAIT_L(0); PG8_BAR; PG8_MMA(1, 0, At, B0); PG8_MMA(1, 1, At, B1); PG8_BAR; PG8_SCHED;
            PG8_LDB(B0, 1, 0); PG8_LDB(B1, 1, 1); PG8_SCHED; PG8_LDA(At, 1, 0); PG8_STAGE(PG8_SA(0, 1), a2 + hstep, voffA);
            PG8_WAIT_V(8); PG8_WAIT_L(0); PG8_BAR; PG8_MMA(0, 0, At, B0); PG8_MMA(0, 1, At, B1); PG8_BAR; PG8_SCHED;
            PG8_LDA(At, 1, 1); PG8_STAGE(PG8_SB(1, 0), b3, voffB); PG8_STAGE(PG8_SB(1, 1), b3 + hstep, voffB); PG8_STAGE(PG8_SA(1, 0), a3, voffA);
            PG8_WAIT_V(8); PG8_WAIT_L(0); PG8_BAR; PG8_MMA(1, 0, At, B0); PG8_MMA(1, 1, At, B1); PG8_BAR; PG8_SCHED;
        }
        if constexpr (ALIGN_EPI) { if (wr == 0) PG8_BAR; }
        E(acc, cur, wr, wc, fr, fq);
        if (!has_next) break;
#pragma unroll
        for (int a = 0; a < 2; ++a)
#pragma unroll
            for (int b = 0; b < 2; ++b)
#pragma unroll
                for (int m = 0; m < 4; ++m)
#pragma unroll
                    for (int n = 0; n < 2; ++n) acc[a][b][m][n] = (f32x4){0.f, 0.f, 0.f, 0.f};
        cur = nxt; cA = nA; cB = nB; ++ui;
        if constexpr (ALIGN_EPI) { if (wr == 1) PG8_BAR; }
    }
    PG8_WAIT_V(0);
    if constexpr (!ALIGN_EPI) { if (wr == 0) PG8_BAR; }
    PG8_BAR;
#undef PG8_SA
#undef PG8_SB
#undef PG8_STAGE
#undef PG8_LDA
#undef PG8_LDB
#undef PG8_MMA
#undef PG8_WAIT_V
#undef PG8_WAIT_L
#undef PG8_BAR
#undef PG8_SCHED
}

typedef f32x4 AccT[2][2][4][2];

struct EpiZ {
    static constexpr bool PERM = true;
    bf16_t* ZB; float* gates; const float* r0; const float* cs; bf16_t* VT16;
    __device__ __forceinline__ void operator()(const AccT& acc, const Unit& u, int wr, int wc, int fr, int fq) const {
        const int row0 = u.pm * BM + wr * 64 + fr; const int pn = u.pn;
        if (pn == 12) {
            if (wc == 0 && fq < 2) {
#pragma unroll
                for (int ai = 0; ai < 2; ++ai)
#pragma unroll
                    for (int m = 0; m < 4; ++m) { const int row = row0 + ai * HALF + m * 16; const float r = r0[row];
                        *(f32x4*)(gates + (size_t)row * 16 + 8 * fq) = acc[ai][0][m][0] * r; *(f32x4*)(gates + (size_t)row * 16 + 8 * fq + 4) = acc[ai][0][m][1] * r; }
            }
            return;
        }
        if (pn == 4 || pn == 5) {
            const int bb_ = u.pm >> 3, m16b = 16 * (u.pm & 7) + 4 * wr;
            float rr[2][4];
#pragma unroll
            for (int ai = 0; ai < 2; ++ai)
#pragma unroll
                for (int m = 0; m < 4; ++m) rr[ai][m] = r0[row0 + ai * HALF + m * 16];
#pragma unroll
            for (int bj = 0; bj < 2; ++bj) { const int hh = (pn - 4) * 4 + 2 * bj + (wc >> 1);
                bf16_t* vb = VT16 + ((size_t)((bb_ * 8 + hh) * 64 + 32 * (wc & 1) + 8 * fq)) * SEQ + fr * 128 + m16b;
#pragma unroll
                for (int ai = 0; ai < 2; ++ai)
#pragma unroll
                    for (int n = 0; n < 2; ++n)
#pragma unroll
                        for (int i = 0; i < 4; ++i) { u32x2 w;
                            w.x = pk2(acc[ai][bj][0][n][i] * rr[ai][0], acc[ai][bj][1][n][i] * rr[ai][1]); w.y = pk2(acc[ai][bj][2][n][i] * rr[ai][2], acc[ai][bj][3][n][i] * rr[ai][3]);
                            *(u32x2*)(vb + (size_t)(4 * n + i) * SEQ + 8 * ai) = w; } }
        }
        const bool rot = (pn < 4) && ((wc & 1) == 0);
        const float qs = (pn < 2) ? 0.125f : 1.0f;
        const int col0 = pn * BM + wc * 32 + 8 * fq;
#pragma unroll
        for (int ai = 0; ai < 2; ++ai)
#pragma unroll
            for (int m = 0; m < 4; ++m) { const int row = row0 + ai * HALF + m * 16; const float r = r0[row] * qs;
                f32x4 cc = {1.f, 1.f, 1.f, 1.f}, sn = {0.f, 0.f, 0.f, 0.f};
                if (rot && fq < 2) { const float* cp = cs + (size_t)row * 16 + 4 * fq; cc = *(const f32x4*)cp; sn = *(const f32x4*)(cp + 8); }
#pragma unroll
                for (int bj = 0; bj < 2; ++bj) { f32x4 v0 = acc[ai][bj][m][0] * r, v1 = acc[ai][bj][m][1] * r;
                    if (rot) { const f32x4 t1 = v0, t2 = v1; v0 = t1 * cc - t2 * sn; v1 = t2 * cc + t1 * sn; }
                    u32x4 w; w.x = pk2(v0[0], v0[1]); w.y = pk2(v0[2], v0[3]); w.z = pk2(v1[0], v1[1]); w.w = pk2(v1[2], v1[3]);
                    *(u32x4*)(ZB + (size_t)row * ZW + col0 + bj * HALF) = w; } }
    }
};

template <bool BASE_BF16> struct EpiRes {
    static constexpr bool PERM = true;
    const float* basef; bf16_t* xb; float* ss;
    __device__ __forceinline__ void operator()(const AccT& acc, const Unit& u, int wr, int wc, int fr, int fq) const {
        const int row0 = u.pm * BM + wr * 64 + fr; const int col0 = u.pn * BM + wc * 32 + 8 * fq;
#pragma unroll
        for (int ai = 0; ai < 2; ++ai)
#pragma unroll
            for (int m = 0; m < 4; ++m) { const int row = row0 + ai * HALF + m * 16; float sq = 0.f;
#pragma unroll
                for (int bj = 0; bj < 2; ++bj) { const size_t off = (size_t)row * DM + col0 + bj * HALF;
                    f32x4 b0, b1;
                    if (BASE_BF16) { const u32x4 g = *(const u32x4*)(xb + off); b0 = (f32x4){bflo(g.x), bfhi(g.x), bflo(g.y), bfhi(g.y)}; b1 = (f32x4){bflo(g.z), bfhi(g.z), bflo(g.w), bfhi(g.w)}; }
                    else { b0 = *(const f32x4*)(basef + off); b1 = *(const f32x4*)(basef + off + 4); }
                    const f32x4 v0 = b0 + acc[ai][bj][m][0], v1 = b1 + acc[ai][bj][m][1];
                    u32x4 w; w.x = pk2(v0[0], v0[1]); w.y = pk2(v0[2], v0[3]); w.z = pk2(v1[0], v1[1]); w.w = pk2(v1[2], v1[3]);
                    *(u32x4*)(xb + off) = w;
                    sq += (v0[0] * v0[0] + v0[1] * v0[1]) + (v0[2] * v0[2] + v0[3] * v0[3]) + (v1[0] * v1[0] + v1[1] * v1[1]) + (v1[2] * v1[2] + v1[3] * v1[3]); }
                sq += __shfl_xor(sq, 16); sq += __shfl_xor(sq, 32);
                if (fq == 0) atomicAdd(ss + row, sq); }
    }
};

struct EpiGate {
    static constexpr bool PERM = true;
    bf16_t* GP; const float* ss;
    __device__ __forceinline__ void operator()(const AccT& acc, const Unit& u, int wr, int wc, int fr, int fq) const {
        const int row0 = u.pm * BM + wr * 64 + fr; const int col0 = u.pn * BM + wc * 32 + 8 * fq;
#pragma unroll
        for (int ai = 0; ai < 2; ++ai)
#pragma unroll
            for (int m = 0; m < 4; ++m) { const int row = row0 + ai * HALF + m * 16; const float r = rsqrtf(ss[row] * (1.0f / DM) + EPSF);
#pragma unroll
                for (int bj = 0; bj < 2; ++bj) { const f32x4 v0 = acc[ai][bj][m][0] * r, v1 = acc[ai][bj][m][1] * r;
                    u32x4 w; w.x = pk2(v0[0], v0[1]); w.y = pk2(v0[2], v0[3]); w.z = pk2(v1[0], v1[1]); w.w = pk2(v1[2], v1[3]);
                    *(u32x4*)(GP + (size_t)row * FF + col0 + bj * HALF) = w; } }
    }
};

struct EpiUp {
    static constexpr bool PERM = true;
    const bf16_t* GP; bf16_t* ACT; const float* ss; const float* cw; const float* cb;
    __device__ __forceinline__ void operator()(const AccT& acc, const Unit& u, int wr, int wc, int fr, int fq) const {
        const int row0 = u.pm * BM + wr * 64 + fr; const int col0 = u.pn * BM + wc * 32 + 8 * fq;
#pragma unroll
        for (int bj = 0; bj < 2; ++bj) { const int col = col0 + bj * HALF;
            f32x4 w0[2], w1[2], w2[2], bb[2];
#pragma unroll
            for (int n = 0; n < 2; ++n) { w0[n] = *(const f32x4*)(cw + col + 4 * n); w1[n] = *(const f32x4*)(cw + FF + col + 4 * n); w2[n] = *(const f32x4*)(cw + 2 * FF + col + 4 * n); bb[n] = *(const f32x4*)(cb + col + 4 * n); }
#pragma unroll
            for (int ai = 0; ai < 2; ++ai)
#pragma unroll
                for (int m = 0; m < 4; ++m) { const int row = row0 + ai * HALF + m * 16; const int s = row & (SEQ - 1); const float r = rsqrtf(ss[row] * (1.0f / DM) + EPSF);
                    const bf16_t* gp = GP + (size_t)row * FF + col;
                    const u32x4 gc = *(const u32x4*)gp;
                    u32x4 gm = {0u, 0u, 0u, 0u}, gn = {0u, 0u, 0u, 0u};
                    if (s > 0) gm = *(const u32x4*)(gp - FF);
                    if (s < SEQ - 1) gn = *(const u32x4*)(gp + FF);
                    float y[8];
#pragma unroll
                    for (int q = 0; q < 4; ++q) { const int n = q >> 1, i0 = (q & 1) * 2;
                        const float a0 = bflo(gm[q]) * w0[n][i0] + bflo(gc[q]) * w1[n][i0] + bflo(gn[q]) * w2[n][i0] + bb[n][i0];
                        const float a1 = bfhi(gm[q]) * w0[n][i0 + 1] + bfhi(gc[q]) * w1[n][i0 + 1] + bfhi(gn[q]) * w2[n][i0 + 1] + bb[n][i0 + 1];
                        y[2 * q] = gelu1(a0) * (acc[ai][bj][m][n][i0] * r); y[2 * q + 1] = gelu1(a1) * (acc[ai][bj][m][n][i0 + 1] * r); }
                    u32x4 w; w.x = pk2(y[0], y[1]); w.y = pk2(y[2], y[3]); w.z = pk2(y[4], y[5]); w.w = pk2(y[6], y[7]);
                    *(u32x4*)(ACT + (size_t)row * FF + col) = w; } }
    }
};

__device__ __forceinline__ float dpp_ror1(float v) { return __builtin_bit_cast(float, __builtin_amdgcn_update_dpp(0, __builtin_bit_cast(int, v), 0x121, 0xF, 0xF, false)); }
__device__ __forceinline__ float dpp_rol1(float v) { return __builtin_bit_cast(float, __builtin_amdgcn_update_dpp(0, __builtin_bit_cast(int, v), 0x12F, 0xF, 0xF, false)); }
struct EpiGU {
    static constexpr bool PERM = true;
    bf16_t* ACT; const float* ss; const float* cw; const float* cb; float* HALO; LAS float* E;
    __device__ __forceinline__ void operator()(const AccT& acc, const Unit& u, int wr, int wc, int fr, int fq) const {
        const int row0 = u.pm * BM + wr * 64 + fr; const int ecol = wc * 32 + 8 * fq; const int colg = u.pn * 128 + ecol;
        float rr[2][4];
#pragma unroll
        for (int ai = 0; ai < 2; ++ai)
#pragma unroll
            for (int m = 0; m < 4; ++m) rr[ai][m] = rsqrtf(ss[row0 + ai * HALF + m * 16] * (1.0f / DM) + EPSF);
#pragma unroll
        for (int ai = 0; ai < 2; ++ai) { const int k = 2 * ai + wr;
            if (fr == 0) { *(LAS f32x4*)(E + (k * 2 + 0) * 128 + ecol) = acc[ai][0][0][0] * rr[ai][0]; *(LAS f32x4*)(E + (k * 2 + 0) * 128 + ecol + 4) = acc[ai][0][0][1] * rr[ai][0]; }
            if (fr == 15) { *(LAS f32x4*)(E + (k * 2 + 1) * 128 + ecol) = acc[ai][0][3][0] * rr[ai][3]; *(LAS f32x4*)(E + (k * 2 + 1) * 128 + ecol + 4) = acc[ai][0][3][1] * rr[ai][3]; } }
        asm volatile("s_waitcnt lgkmcnt(0)" ::: "memory"); __builtin_amdgcn_s_barrier(); asm volatile("" ::: "memory");
        f32x4 w0[2], w1[2], w2[2], bb[2];
#pragma unroll
        for (int n = 0; n < 2; ++n) { w0[n] = *(const f32x4*)(cw + colg + 4 * n); w1[n] = *(const f32x4*)(cw + FF + colg + 4 * n); w2[n] = *(const f32x4*)(cw + 2 * FF + colg + 4 * n); bb[n] = *(const f32x4*)(cb + colg + 4 * n); }
#pragma unroll
        for (int ai = 0; ai < 2; ++ai) { const int k = 2 * ai + wr;
            f32x4 pe[2], ne[2];
#pragma unroll
            for (int n = 0; n < 2; ++n) { pe[n] = (f32x4){0.f, 0.f, 0.f, 0.f}; ne[n] = pe[n];
                if (k > 0) pe[n] = *(const LAS f32x4*)(E + ((k - 1) * 2 + 1) * 128 + ecol + 4 * n);
                if (k < 3) ne[n] = *(const LAS f32x4*)(E + ((k + 1) * 2 + 0) * 128 + ecol + 4 * n); }
            f32x4 g[4][2];
#pragma unroll
            for (int m = 0; m < 4; ++m)
#pragma unroll
                for (int n = 0; n < 2; ++n) g[m][n] = acc[ai][0][m][n] * rr[ai][m];
            f32x4 rorPrev[2] = {pe[0], pe[1]}, rolCur[2];
#pragma unroll
            for (int n = 0; n < 2; ++n)
#pragma unroll
                for (int i = 0; i < 4; ++i) rolCur[n][i] = dpp_rol1(g[0][n][i]);
#pragma unroll
            for (int m = 0; m < 4; ++m) { const int row = row0 + ai * HALF + m * 16;
                f32x4 pv[2], nv[2], rolNext[2];
#pragma unroll
                for (int n = 0; n < 2; ++n)
#pragma unroll
                    for (int i = 0; i < 4; ++i) { const float rc = dpp_ror1(g[m][n][i]); pv[n][i] = fr > 0 ? rc : rorPrev[n][i]; rorPrev[n][i] = rc;
                        rolNext[n][i] = (m < 3) ? dpp_rol1(g[m < 3 ? m + 1 : 3][n][i]) : ne[n][i]; nv[n][i] = fr < 15 ? rolCur[n][i] : rolNext[n][i]; rolCur[n][i] = rolNext[n][i]; }
                const bool top = (k == 0 && m == 0 && fr == 0), bot = (k == 3 && m == 3 && fr == 15);
                float y[8];
#pragma unroll
                for (int n = 0; n < 2; ++n) { const f32x4 uu = acc[ai][1][m][n] * rr[ai][m];
                    const f32x4 amid = g[m][n] * w1[n] + bb[n]; const f32x4 a = pv[n] * w0[n] + (amid + nv[n] * w2[n]);
#pragma unroll
                    for (int i = 0; i < 4; ++i) y[4 * n + i] = gelu1(a[i]) * uu[i];
                    if (top) { float* H = HALO + (size_t)((u.pm * 2 + 0) * 3) * FF + colg + 4 * n; *(f32x4*)H = g[m][n]; *(f32x4*)(H + FF) = amid + nv[n] * w2[n]; *(f32x4*)(H + 2 * FF) = uu; }
                    if (bot) { float* H = HALO + (size_t)((u.pm * 2 + 1) * 3) * FF + colg + 4 * n; *(f32x4*)H = g[m][n]; *(f32x4*)(H + FF) = pv[n] * w0[n] + amid; *(f32x4*)(H + 2 * FF) = uu; } }
                u32x4 w; w.x = pk2(y[0], y[1]); w.y = pk2(y[2], y[3]); w.z = pk2(y[4], y[5]); w.w = pk2(y[6], y[7]);
                *(u32x4*)(ACT + (size_t)row * FF + colg) = w; }
        }
    }
};

struct EpiStore {
    static constexpr bool PERM = true;
    bf16_t* O;
    __device__ __forceinline__ void operator()(const AccT& acc, const Unit& u, int wr, int wc, int fr, int fq) const {
        const int row0 = u.pm * BM + wr * 64 + fr; const int col0 = u.pn * BM + wc * 32 + 8 * fq;
#pragma unroll
        for (int ai = 0; ai < 2; ++ai)
#pragma unroll
            for (int m = 0; m < 4; ++m) { const int row = row0 + ai * HALF + m * 16;
#pragma unroll
                for (int bj = 0; bj < 2; ++bj) { const f32x4 v0 = acc[ai][bj][m][0], v1 = acc[ai][bj][m][1];
                    u32x4 w; w.x = pk2(v0[0], v0[1]); w.y = pk2(v0[2], v0[3]); w.z = pk2(v1[0], v1[1]); w.w = pk2(v1[2], v1[3]);
                    *(u32x4*)(O + (size_t)row * DM + col0 + bj * HALF) = w; } }
    }
};

struct EpiSigPle {
    static constexpr bool PERM = true;
    bf16_t* xb; const bf16_t* PP; const float* ssin; const float* bias; float* ss;
    __device__ __forceinline__ void operator()(const AccT& acc, const Unit& u, int wr, int wc, int fr, int fq) const {
        const int row0 = u.pm * BM + wr * 64 + fr; const int col0 = u.pn * BM + wc * 32 + 8 * fq;
#pragma unroll
        for (int ai = 0; ai < 2; ++ai)
#pragma unroll
            for (int m = 0; m < 4; ++m) { const int row = row0 + ai * HALF + m * 16; const float r = rsqrtf(ssin[row] * (1.0f / DM) + EPSF); float sq = 0.f;
#pragma unroll
                for (int bj = 0; bj < 2; ++bj) { const size_t off = (size_t)row * DM + col0 + bj * HALF;
                    const u32x4 xbv = *(const u32x4*)(xb + off); const u32x4 pv = *(const u32x4*)(PP + off);
                    const f32x4 x0 = {bflo(xbv.x), bfhi(xbv.x), bflo(xbv.y), bfhi(xbv.y)}, x1 = {bflo(xbv.z), bfhi(xbv.z), bflo(xbv.w), bfhi(xbv.w)};
                    const f32x4 p0 = {bflo(pv.x), bfhi(pv.x), bflo(pv.y), bfhi(pv.y)}, p1 = {bflo(pv.z), bfhi(pv.z), bflo(pv.w), bfhi(pv.w)};
                    const f32x4 a0 = acc[ai][bj][m][0] * r + *(const f32x4*)(bias + col0 + bj * HALF), a1 = acc[ai][bj][m][1] * r + *(const f32x4*)(bias + col0 + bj * HALF + 4);
                    const f32x4 s0 = {sigmoidf_(a0[0]), sigmoidf_(a0[1]), sigmoidf_(a0[2]), sigmoidf_(a0[3])}, s1 = {sigmoidf_(a1[0]), sigmoidf_(a1[1]), sigmoidf_(a1[2]), sigmoidf_(a1[3])};
                    const f32x4 v0 = x0 + p0 * s0, v1 = x1 + p1 * s1;
                    u32x4 w; w.x = pk2(v0[0], v0[1]); w.y = pk2(v0[2], v0[3]); w.z = pk2(v1[0], v1[1]); w.w = pk2(v1[2], v1[3]);
                    *(u32x4*)(xb + off) = w;
                    sq += (v0[0] * v0[0] + v0[1] * v0[1]) + (v0[2] * v0[2] + v0[3] * v0[3]) + (v1[0] * v1[0] + v1[1] * v1[1]) + (v1[2] * v1[2] + v1[3] * v1[3]); }
                sq += __shfl_xor(sq, 16); sq += __shfl_xor(sq, 32);
                if (fq == 0) atomicAdd(ss + row, sq);
                asm volatile("" ::: "memory"); }
    }
};
}

__device__ __forceinline__ void transpose_item(const float* W, int K, int N, int nblk, const float* gk, bf16_t* WT, LAS float* scr, int item, int lane, int rowmode = 0) {
    const int kb = item / nblk, nb = item % nblk, k0 = 64 * kb, n0 = 32 * nb;
    const int d0 = (rowmode == 1 || rowmode == 2) ? (256 * (n0 >> 7) + (n0 & 127) + (rowmode == 2 ? 128 : 0)) : n0;
    const int n = n0 + (lane & 31);
#pragma unroll 8
    for (int i = 0; i < 32; ++i) { const int kk = 2 * i + (lane >> 5); float v = 0.f; if (n < N) v = __builtin_nontemporal_load(&W[(size_t)(k0 + kk) * N + n]); if (gk) v *= gk[k0 + kk]; scr[kk * 33 + (lane & 31)] = v; }
    asm volatile("s_waitcnt lgkmcnt(0)" ::: "memory");
    const int c = lane & 7;
#pragma unroll
    for (int j = 0; j < 4; ++j) { const int nn = (lane >> 3) + 8 * j; const LAS float* s = scr + (8 * c) * 33 + nn;
        u32x4 o; o.x = pk2(s[0 * 33], s[1 * 33]); o.y = pk2(s[2 * 33], s[3 * 33]); o.z = pk2(s[4 * 33], s[5 * 33]); o.w = pk2(s[6 * 33], s[7 * 33]);
        const int nd = (rowmode == 3 && n0 < 1024 && (n0 & 63) == 0 && nn >= 4 && nn < 12) ? (nn ^ 12) : nn;
        *(u32x4*)(WT + (size_t)(d0 + nd) * K + k0 + 8 * c) = o; }
    asm volatile("s_waitcnt lgkmcnt(0)" ::: "memory");
}

__device__ __forceinline__ void phase_prologue(const Params& P, LAS unsigned char* lds, int G) {
    int tid = threadIdx.x; asm volatile("" : "+v"(tid));
    const int lane = tid & 63, wave = tid >> 6;
    const int gw = blockIdx.x * 8 + wave, NGW = G * 8;
    unsigned char* ws = P.ws;
    LAS float* scr = (LAS float*)(lds + wave * 16384);
    constexpr int I_IN = 16 * (NZPAD / 32), I_OUT = 16 * 32, I_G = 16 * (FF / 32), I_D = (FF / 64) * 32, I_PP = 4 * 32;
    constexpr int NITEMS = I_IN + I_OUT + 2 * I_G + I_D + I_OUT + I_PP;
    for (int it = gw; it < NITEMS; it += NGW) {
        int r = it;
        if (r < I_IN) { transpose_item(P.w_in, DM, NIN, NZPAD / 32, P.ln_mix_g, (bf16_t*)(ws + WS_WIN), scr, r, lane, 3); continue; } r -= I_IN;
        if (r < I_OUT) { transpose_item(P.w_out, DM, DM, 32, nullptr, (bf16_t*)(ws + WS_WOUT), scr, r, lane); continue; } r -= I_OUT;
        if (r < I_G) { transpose_item(P.w_fg, DM, FF, FF / 32, P.ln_ffn_g, (bf16_t*)(ws + WS_WG), scr, r, lane, 1); continue; } r -= I_G;
        if (r < I_G) { transpose_item(P.w_fu, DM, FF, FF / 32, P.ln_ffn_g, (bf16_t*)(ws + WS_WG), scr, r, lane, 2); continue; } r -= I_G;
        if (r < I_D) { transpose_item(P.w_fd, FF, DM, 32, nullptr, (bf16_t*)(ws + WS_WD), scr, r, lane); continue; } r -= I_D;
        if (r < I_OUT) { transpose_item(P.w_pg, DM, DM, 32, P.ln_ple_g, (bf16_t*)(ws + WS_WPG), scr, r, lane); continue; } r -= I_OUT;
        transpose_item(P.w_pp, 256, DM, 32, nullptr, (bf16_t*)(ws + WS_WPP), scr, r, lane);
    }
    float* r0 = (float*)(ws + WS_R0); float* cs = (float*)(ws + WS_CS);
    bf16_t* XB = (bf16_t*)(ws + WS_XB); bf16_t* PB = (bf16_t*)(ws + WS_PB);
    for (int m0 = gw; m0 < MTOK; m0 += 2 * NGW) {
        const int m1 = (m0 + NGW < MTOK) ? m0 + NGW : m0;
        f32x4 v[2][4]; f32x4 pv[2]; int ps[2];
#pragma unroll
        for (int q = 0; q < 2; ++q) { const int m = q ? m1 : m0; const f32x4* xr = (const f32x4*)(P.x + (size_t)m * DM) + lane;
#pragma unroll
            for (int j = 0; j < 4; ++j) v[q][j] = __builtin_nontemporal_load(xr + 64 * j);
            pv[q] = __builtin_nontemporal_load((const f32x4*)(P.p + (size_t)m * 256) + lane); ps[q] = P.pos[m]; }
#pragma unroll
        for (int q = 0; q < 2; ++q) { const int m = q ? m1 : m0;
            if (q == 1 && m1 == m0) break;
            float s = 0.f;
#pragma unroll
            for (int j = 0; j < 4; ++j) s += (v[q][j].x * v[q][j].x + v[q][j].y * v[q][j].y) + (v[q][j].z * v[q][j].z + v[q][j].w * v[q][j].w);
            s = wave_sum(s);
            u32x2* o8 = (u32x2*)(XB + (size_t)m * DM) + lane;
#pragma unroll
            for (int j = 0; j < 4; ++j) { u32x2 w; w.x = pk2(v[q][j].x, v[q][j].y); w.y = pk2(v[q][j].z, v[q][j].w); o8[64 * j] = w; }
            if (lane == 0) r0[m] = rsqrtf(s * (1.0f / DM) + EPSF);
            u32x2 pw; pw.x = pk2(pv[q].x, pv[q].y); pw.y = pk2(pv[q].z, pv[q].w);
            *((u32x2*)(PB + (size_t)m * 256) + lane) = pw;
            if (lane < 8) {
                const double rev = (double)ps[q] * P.invrev[lane];
                const float fr = (float)(rev - floor(rev));
                cs[(size_t)m * 16 + lane] = __builtin_amdgcn_cosf(fr);
                cs[(size_t)m * 16 + 8 + lane] = __builtin_amdgcn_sinf(fr);
            } }
    }
    float* ssz = (float*)(ws + WS_SS1);
    for (int i = blockIdx.x * 512 + tid; i < 3 * MTOK; i += G * 512) ssz[i] = 0.f;
}

__device__ __forceinline__ void vtrans_unit(const Params& P, LAS unsigned char* lds, int unit) {
    int tid = threadIdx.x; asm volatile("" : "+v"(tid));
    const int blk = unit & 7, h = (unit >> 3) & 7, b = unit >> 6;
    const int s0 = blk * 256;
    unsigned char* ws = P.ws;
    const bf16_t* ZB = (const bf16_t*)(ws + WS_ZB);
    LAS bf16_t* tile = (LAS bf16_t*)lds;
    __syncthreads();
#pragma unroll
    for (int i = 0; i < 4; ++i) { const int ch = tid + 512 * i; const int t = ch >> 3, dc = ch & 7;
        const u32x4 v = *(const u32x4*)(ZB + (size_t)(b * SEQ + s0 + t) * ZW + 1024 + h * 64 + dc * 8);
        LAS unsigned* dst = (LAS unsigned*)(tile + t * 66 + dc * 8);
        dst[0] = v.x; dst[1] = v.y; dst[2] = v.z; dst[3] = v.w; }
    __syncthreads();
    const size_t hb = (size_t)((b * 8 + h) * 64) * SEQ;
    bf16_t* V1 = (bf16_t*)(ws + WS_VT1) + hb; bf16_t* V4 = (bf16_t*)(ws + WS_VT4) + hb; bf16_t* V16 = (bf16_t*)(ws + WS_VT16) + hb;
#pragma unroll
    for (int i = 0; i < 4; ++i) { const int ch = tid + 512 * i; const int d = ch >> 5, t8 = ch & 31;
        unsigned short e[8];
#pragma unroll
        for (int k = 0; k < 8; ++k) e[k] = tile[(t8 * 8 + k) * 66 + d];
        u32x4 w; w.x = e[0] | ((unsigned)e[1] << 16); w.y = e[2] | ((unsigned)e[3] << 16); w.z = e[4] | ((unsigned)e[5] << 16); w.w = e[6] | ((unsigned)e[7] << 16);
        *(u32x4*)(V1 + (size_t)d * SEQ + s0 + t8 * 8) = w; }
#pragma unroll
    for (int i = 0; i < 4; ++i) { const int ch = tid + 512 * i; const int d = ch >> 5, r = (ch >> 3) & 3, m8 = ch & 7;
        unsigned short e[8];
#pragma unroll
        for (int k = 0; k < 8; ++k) e[k] = tile[(4 * (m8 * 8 + k) + r) * 66 + d];
        u32x4 w; w.x = e[0] | ((unsigned)e[1] << 16); w.y = e[2] | ((unsigned)e[3] << 16); w.z = e[4] | ((unsigned)e[5] << 16); w.w = e[6] | ((unsigned)e[7] << 16);
        *(u32x4*)(V4 + (size_t)d * SEQ + r * 512 + (s0 >> 2) + m8 * 8) = w; }
#pragma unroll
    for (int i = 0; i < 4; ++i) { const int ch = tid + 512 * i; const int d = ch >> 5, r = (ch >> 1) & 15, m8 = ch & 1;
        unsigned short e[8];
#pragma unroll
        for (int k = 0; k < 8; ++k) e[k] = tile[(16 * (m8 * 8 + k) + r) * 66 + d];
        u32x4 w; w.x = e[0] | ((unsigned)e[1] << 16); w.y = e[2] | ((unsigned)e[3] << 16); w.z = e[4] | ((unsigned)e[5] << 16); w.w = e[6] | ((unsigned)e[7] << 16);
        *(u32x4*)(V16 + (size_t)d * SEQ + r * 128 + (s0 >> 4) + m8 * 8) = w; }
}

constexpr int SC_UC = 0, SC_P = 0  , SC_Q = 17408, SC_K = 34816, SC_KW = 52224, SC_VT = 70656, SC_CB = 91392, SC_F = 130560;
constexpr int NE = 144, NCT = 9;
__device__ __forceinline__ void scan_item(const Params& P, LAS unsigned char* lds, int item) {
    int tid = threadIdx.x; asm volatile("" : "+v"(tid));
    const int lane = tid & 63, w = __builtin_amdgcn_readfirstlane(tid >> 6), qi = lane & 15, quad = lane >> 4;
    const int dir = item & 1, h = (item >> 1) & 3, b = item >> 3;
    unsigned char* ws = P.ws;
    const bf16_t* ZB = (const bf16_t*)(ws + WS_ZB);
    const float* gates = (const float*)(ws + WS_GATES);
    bf16_t* HB = (bf16_t*)P.out + (dir ? (size_t)MTOK * 512 : 0);
    LAS bf16_t* ucS = (LAS bf16_t*)(lds + SC_UC); LAS bf16_t* qS = (LAS bf16_t*)(lds + SC_Q); LAS bf16_t* kS = (LAS bf16_t*)(lds + SC_K);
    LAS bf16_t* kwT = (LAS bf16_t*)(lds + SC_KW); LAS bf16_t* vT = (LAS bf16_t*)(lds + SC_VT); LAS bf16_t* pS = (LAS bf16_t*)(lds + SC_P); LAS bf16_t* CbT = (LAS bf16_t*)(lds + SC_CB);
    LAS float* cS = (LAS float*)(lds + SC_F); LAS float* MS = cS + 64; LAS float* aS = cS + 128; LAS float* eS = cS + 192; LAS float* wS = cS + 256; LAS float* denS = cS + 320; LAS float* misc = cS + 384;
    __syncthreads();
    bf16x8 wqf[4], wkf[4];
    {
        const float* wq = P.w_mq + (size_t)h * 128 * 128 + 16 * w + qi; const float* wk = P.w_mk + (size_t)h * 128 * 128 + 16 * w + qi;
        const float ksc = 0.08838834764831845f;
#pragma unroll
        for (int ks = 0; ks < 4; ++ks)
#pragma unroll
            for (int i = 0; i < 8; ++i) { const int d = ks * 32 + quad * 8 + i; wqf[ks][i] = (short)f2bf(wq[(size_t)d * 128]); wkf[ks][i] = (short)f2bf(wk[(size_t)d * 128] * ksc); }
    }
    for (int i = tid; i < NE * 136 / 2; i += 512) ((LAS unsigned*)CbT)[i] = 0u;
    for (int i = tid; i < 16 * 72; i += 512) vT[128 * 72 + i] = (i < 72) ? (bf16_t)0x3F80 : (bf16_t)0;
    f32x4 C[NCT];
#pragma unroll
    for (int ct = 0; ct < NCT; ++ct) C[ct] = (f32x4){0.f, 0.f, 0.f, 0.f};
    float m_run = 0.f;
    const float big = P.b_ig[dir * 4 + h], bfg = P.b_fg[dir * 4 + h];
    __syncthreads();
    u32x4 uc0, uc1, um0, um1, un0, un1, vvA, vvB; float pig = 0.f, pfg = 0.f;
#define SCAN_PREFETCH(cidx) do { const int cc_ = dir ? 31 - (cidx) : (cidx); const int t0_ = cc_ * 64; \
        { const int s_ = tid >> 3, dc_ = tid & 7; const int pos_ = dir ? t0_ + 63 - s_ : t0_ + s_; const size_t tok_ = (size_t)b * SEQ + pos_; \
          const bf16_t* up_ = ZB + tok_ * ZW + 1536 + h * 128 + dc_ * 16; \
          uc0 = *(const u32x4*)up_; uc1 = *(const u32x4*)(up_ + 8); \
          um0 = (u32x4){0u, 0u, 0u, 0u}; um1 = um0; un0 = um0; un1 = um0; \
          if (pos_ > 0) { um0 = *(const u32x4*)(up_ - ZW); um1 = *(const u32x4*)(up_ - ZW + 8); } \
          if (pos_ < SEQ - 1) { un0 = *(const u32x4*)(up_ + ZW); un1 = *(const u32x4*)(up_ + ZW + 8); } \
          vvA = *(const u32x4*)(ZB + tok_ * ZW + 2048 + h * 128 + dc_ * 16); vvB = *(const u32x4*)(ZB + tok_ * ZW + 2048 + h * 128 + dc_ * 16 + 8); } \
        if (w == 0) { const int pos_ = dir ? t0_ + 63 - lane : t0_ + lane; const size_t tok_ = (size_t)b * SEQ + pos_; \
          pig = gates[tok_ * 16 + dir * 4 + h]; pfg = gates[tok_ * 16 + 8 + dir * 4 + h]; } } while (0)
    SCAN_PREFETCH(0);
    for (int c = 0; c < 32; ++c) {
        const int cc = dir ? 31 - c : c; const int t0 = cc * 64;
        if (w == 0) {
            const float ig = pig + big; const float fg = pfg + bfg;
            const float lf = fminf(fg, 0.f) - log1pf(__expf(-fabsf(fg)));
            float bs = lf;
#pragma unroll
            for (int o = 1; o < 64; o <<= 1) { const float t = __shfl_up(bs, o); if (lane >= o) bs += t; }
            const float cv = ig - bs; float pm = cv;
#pragma unroll
            for (int o = 1; o < 64; o <<= 1) { const float t = __shfl_up(pm, o); if (lane >= o) pm = fmaxf(pm, t); }
            const float Mt = fmaxf(m_run, pm);
            const float M63 = __shfl(Mt, 63), g = __shfl(bs, 63);
            cS[lane] = cv; MS[lane] = Mt; aS[lane] = __expf(m_run - Mt); eS[lane] = __expf(-(bs + Mt)); wS[lane] = __expf(cv - M63);
            if (lane == 0) misc[0] = __expf(m_run - M63);
            m_run = g + M63;
        }
        {
            const int s = tid >> 3, dc = tid & 7; const int pos = dir ? t0 + 63 - s : t0 + s; const size_t tok = (size_t)b * SEQ + pos;
            const int ch = h * 128 + dc * 16;
            unsigned ow[8];
#pragma unroll
            for (int q = 0; q < 8; ++q) { const unsigned m_ = q < 4 ? um0[q & 3] : um1[q & 3], c_ = q < 4 ? uc0[q & 3] : uc1[q & 3], n_ = q < 4 ? un0[q & 3] : un1[q & 3];
                const int cch = ch + 2 * q;
                const float a0 = bflo(m_) * P.mconv_w[cch] + bflo(c_) * P.mconv_w[512 + cch] + bflo(n_) * P.mconv_w[1024 + cch] + P.mconv_b[cch];
                const float a1 = bfhi(m_) * P.mconv_w[cch + 1] + bfhi(c_) * P.mconv_w[512 + cch + 1] + bfhi(n_) * P.mconv_w[1024 + cch + 1] + P.mconv_b[cch + 1];
                ow[q] = pk2(a0 * sigmoidf_(a0), a1 * sigmoidf_(a1)); }
            LAS u32x4* dst = (LAS u32x4*)(ucS + s * 136 + dc * 16);
            dst[0] = (u32x4){ow[0], ow[1], ow[2], ow[3]}; dst[1] = (u32x4){ow[4], ow[5], ow[6], ow[7]};
            const int e0 = dc * 16;
            const int sc_ = (s + 8 * dc) & 63;
#pragma unroll
            for (int q = 0; q < 4; ++q) { const unsigned wa = vvA[q], wb = vvB[q];
                vT[(e0 + 2 * q) * 72 + sc_] = (bf16_t)(wa & 0xffff); vT[(e0 + 2 * q + 1) * 72 + sc_] = (bf16_t)(wa >> 16);
                vT[(e0 + 8 + 2 * q) * 72 + sc_] = (bf16_t)(wb & 0xffff); vT[(e0 + 8 + 2 * q + 1) * 72 + sc_] = (bf16_t)(wb >> 16); }
        }
        __syncthreads();
        { const int cn = c < 31 ? c + 1 : 31; SCAN_PREFETCH(cn); }
#pragma unroll
        for (int st = 0; st < 4; ++st) {
            f32x4 aq = {0.f, 0.f, 0.f, 0.f}, ak = aq;
            const int s = st * 16 + qi;
#pragma unroll
            for (int ks = 0; ks < 4; ++ks) { const bf16x8 uf = *(const LAS bf16x8*)(ucS + s * 136 + ks * 32 + quad * 8);
                aq = __builtin_amdgcn_mfma_f32_16x16x32_bf16(wqf[ks], uf, aq, 0, 0, 0); ak = __builtin_amdgcn_mfma_f32_16x16x32_bf16(wkf[ks], uf, ak, 0, 0, 0); }
            const int e = 16 * w + quad * 4;
            u32x2 qw; qw.x = pk2(aq[0], aq[1]); qw.y = pk2(aq[2], aq[3]); *(LAS u32x2*)(qS + s * 136 + e) = qw;
            u32x2 kw; kw.x = pk2(ak[0], ak[1]); kw.y = pk2(ak[2], ak[3]); *(LAS u32x2*)(kS + s * 136 + e) = kw;
            const float wsv = wS[s];
#pragma unroll
            for (int j = 0; j < 4; ++j) kwT[(e + j) * 72 + s] = (bf16_t)f2bf(ak[j] * wsv);
        }
        __syncthreads();
        {
            const int tt = w >> 1; const int t = tt * 16 + qi; const float Mt = MS[t];
#pragma unroll
            for (int si = 0; si < 2; ++si) { const int st = (w & 1) * 2 + si; const int srow = st * 16 + qi;
                f32x4 sa = {0.f, 0.f, 0.f, 0.f};
#pragma unroll
                for (int ks = 0; ks < 4; ++ks) { const bf16x8 kf = *(const LAS bf16x8*)(kS + srow * 136 + ks * 32 + quad * 8); const bf16x8 qf = *(const LAS bf16x8*)(qS + t * 136 + ks * 32 + quad * 8);
                    sa = __builtin_amdgcn_mfma_f32_16x16x32_bf16(kf, qf, sa, 0, 0, 0); }
                float pv[4];
#pragma unroll
                for (int j = 0; j < 4; ++j) { const int s = st * 16 + quad * 4 + j; pv[j] = (s <= t) ? sa[j] * __expf(cS[s] - Mt) : 0.f; }
                u32x2 pw; pw.x = pk2(pv[0], pv[1]); pw.y = pk2(pv[2], pv[3]); *(LAS u32x2*)(pS + t * 72 + st * 16 + quad * 4) = pw; }
        }
        __syncthreads();
        {
            const int tt = w >> 1; const int t = tt * 16 + qi; const float at = aS[t];
            const int ct0 = (w & 1) ? 5 : 0; const int nct = (w & 1) ? 4 : 5;
            f32x4 na[5];
#pragma unroll
            for (int ci = 0; ci < 5; ++ci) { na[ci] = (f32x4){0.f, 0.f, 0.f, 0.f};
                if (ci < nct) { const int ep = (ct0 + ci) * 16 + qi;
#pragma unroll
                    for (int ks = 0; ks < 4; ++ks) { const bf16x8 cf = *(const LAS bf16x8*)(CbT + ep * 136 + ks * 32 + quad * 8); const bf16x8 qf = *(const LAS bf16x8*)(qS + t * 136 + ks * 32 + quad * 8);
                        na[ci] = __builtin_amdgcn_mfma_f32_16x16x32_bf16(cf, qf, na[ci], 0, 0, 0); }
                    na[ci] = na[ci] * at;
#pragma unroll
                    for (int ks = 0; ks < 2; ++ks) { const bf16x8 vf = *(const LAS bf16x8*)(vT + ep * 72 + ((ks * 32 + quad * 8 + 8 * (ep >> 4)) & 63)); const bf16x8 pf = *(const LAS bf16x8*)(pS + t * 72 + ks * 32 + quad * 8);
                        na[ci] = __builtin_amdgcn_mfma_f32_16x16x32_bf16(vf, pf, na[ci], 0, 0, 0); } } }
            if ((w & 1) && quad == 0) denS[t] = na[3][0];
            __syncthreads();
            const float den = denS[t]; const float dn = fmaxf(fabsf(den), eS[t]); const float inv = 1.0f / dn;
            const int pos = dir ? t0 + 63 - t : t0 + t; const size_t tok = (size_t)b * SEQ + pos;
#pragma unroll
            for (int ci = 0; ci < 5; ++ci) { const int ct = ct0 + ci;
                if (ci < nct && ct < 8) { u32x2 hw; hw.x = pk2(na[ci][0] * inv, na[ci][1] * inv); hw.y = pk2(na[ci][2] * inv, na[ci][3] * inv);
                    *(u32x2*)(HB + tok * 512 + h * 128 + ct * 16 + quad * 4) = hw; } }
        }
        {
            const float decay = misc[0];
            const int drow = 16 * w + qi;
            bf16x8 kf[2];
#pragma unroll
            for (int ks = 0; ks < 2; ++ks) kf[ks] = *(const LAS bf16x8*)(kwT + drow * 72 + ks * 32 + quad * 8);
#pragma unroll
            for (int ct = 0; ct < NCT; ++ct) { C[ct] = C[ct] * decay;
#pragma unroll
                for (int ks = 0; ks < 2; ++ks) { const bf16x8 vf = *(const LAS bf16x8*)(vT + (ct * 16 + qi) * 72 + ((ks * 32 + quad * 8 + 8 * ct) & 63));
                    C[ct] = __builtin_amdgcn_mfma_f32_16x16x32_bf16(kf[ks], vf, C[ct], 0, 0, 0); }
                u32x2 cw; cw.x = pk2(C[ct][0], C[ct][1]); cw.y = pk2(C[ct][2], C[ct][3]);
                *(LAS u32x2*)(CbT + (ct * 16 + qi) * 136 + 16 * w + quad * 4) = cw; }
        }
        __syncthreads();
    }
}

__device__ __forceinline__ int iclamp(int v, int lo, int hi) { return v < lo ? lo : (v > hi ? hi : v); }
__device__ __forceinline__ void attn_step(const bf16x8 (&kf)[2][2], const bf16x8 (&vf)[4], const bf16x8 (&qf)[2], f32x4 (&o)[4], float& mrun, float& lrun,
                                          int k0, int M, int mq, int quad) {
    f32x4 sa[2];
#pragma unroll
    for (int T = 0; T < 2; ++T) { sa[T] = (f32x4){0.f, 0.f, 0.f, 0.f};
        sa[T] = __builtin_amdgcn_mfma_f32_16x16x32_bf16(kf[T][0], qf[0], sa[T], 0, 0, 0);
        sa[T] = __builtin_amdgcn_mfma_f32_16x16x32_bf16(kf[T][1], qf[1], sa[T], 0, 0, 0); }
    float sc[8]; float mx = -1e30f;
#pragma unroll
    for (int T = 0; T < 2; ++T)
#pragma unroll
        for (int jj = 0; jj < 4; ++jj) { const int kk = k0 + 8 * quad + 4 * T + jj; const int dq = kk - mq;
            const bool valid = (kk >= 0) && (kk < M) && (dq >= -64) && (dq <= 64);
            const float sv = valid ? sa[T][jj] : -1e30f; sc[T * 4 + jj] = sv; mx = fmaxf(mx, sv); }
    mx = fmaxf(mx, __shfl_xor(mx, 16)); mx = fmaxf(mx, __shfl_xor(mx, 32));
    const float mnew = fmaxf(mrun, mx); const float scale = __expf(mrun - mnew); mrun = mnew;
    float ps[8]; float lsum = 0.f;
#pragma unroll
    for (int i = 0; i < 8; ++i) { ps[i] = __expf(sc[i] - mnew); lsum += ps[i]; }
    lrun = lrun * scale + lsum;
    const u32x4 pwv = {pk2(ps[0], ps[1]), pk2(ps[2], ps[3]), pk2(ps[4], ps[5]), pk2(ps[6], ps[7])};
    const bf16x8 pf = __builtin_bit_cast(bf16x8, pwv);
#pragma unroll
    for (int dt = 0; dt < 4; ++dt) { o[dt] = o[dt] * scale; o[dt] = __builtin_amdgcn_mfma_f32_16x16x32_bf16(vf[dt], pf, o[dt], 0, 0, 0); }
}

constexpr int AT_KS = 0, AT_VS = 55296;
__device__ __forceinline__ void attn_unit(const Params& P, LAS unsigned char* lds, int b, int h, int blk, int tid) {
    const int lane = tid & 63, wave = tid >> 6, qi = lane & 15, quad = lane >> 4;
    const int krow = 8 * (qi >> 2) + (qi & 3);
    unsigned char* ws = P.ws;
    const bf16_t* ZB = (const bf16_t*)(ws + WS_ZB);
    bf16_t* MIX = (bf16_t*)(ws + WS_MIX);
    const int s0 = blk * 256;
    const size_t hb = (size_t)((b * 8 + h) * 64) * SEQ;
    LAS bf16_t* Ks = (LAS bf16_t*)(lds + AT_KS); LAS bf16_t* Vs = (LAS bf16_t*)(lds + AT_VS);
    __syncthreads();
    {
        int tl = tid; asm volatile("" : "+v"(tl));
#pragma unroll
        for (int i = 0; i < 6; ++i) { const int c = tl + 512 * i; const int row = c >> 3, ch = c & 7; const int pos = s0 - 64 + row;
            u32x4 kv = {0u, 0u, 0u, 0u}, vv = kv;
            if (pos >= 0 && pos < SEQ) { const bf16_t* zp = ZB + ((size_t)b * SEQ + pos) * ZW + h * 64 + ch * 8; kv = *(const u32x4*)(zp + 512); vv = *(const u32x4*)(zp + 1024); }
            *(LAS u32x4*)(Ks + row * 72 + ch * 8) = kv;
            const int colw = row + 8 * ch; LAS bf16_t* vd = Vs + (ch * 8) * 392 + (colw >= 384 ? colw - 384 : colw);
            vd[0 * 392] = (bf16_t)(vv.x & 0xffff); vd[1 * 392] = (bf16_t)(vv.x >> 16); vd[2 * 392] = (bf16_t)(vv.y & 0xffff); vd[3 * 392] = (bf16_t)(vv.y >> 16);
            vd[4 * 392] = (bf16_t)(vv.z & 0xffff); vd[5 * 392] = (bf16_t)(vv.z >> 16); vd[6 * 392] = (bf16_t)(vv.w & 0xffff); vd[7 * 392] = (bf16_t)(vv.w >> 16); }
    }
    int jj2[2], posq[2]; size_t tokq[2];
    bf16x8 qf[2][2]; f32x4 o[2][4]; float mrun[2], lrun[2];
#pragma unroll
    for (int t = 0; t < 2; ++t) { jj2[t] = 4 * (wave >> 1) + (wave & 1) + 2 * t;     posq[t] = s0 + jj2[t] + 16 * qi; tokq[t] = (size_t)b * SEQ + posq[t];
#pragma unroll
        for (int ks = 0; ks < 2; ++ks) qf[t][ks] = *(const bf16x8*)(ZB + tokq[t] * ZW + h * 64 + ks * 32 + quad * 8);
#pragma unroll
        for (int dt = 0; dt < 4; ++dt) o[t][dt] = (f32x4){0.f, 0.f, 0.f, 0.f};
        mrun[t] = -1e30f; lrun[t] = 0.f; }
    const bf16_t* Kb = ZB + (size_t)b * SEQ * ZW + 512 + h * 64 + quad * 8;
    {
        const int dil = 16, M = 128; int r[2], mq[2]; const bf16_t* VT[2];
#pragma unroll
        for (int t = 0; t < 2; ++t) { r[t] = jj2[t]; mq[t] = blk * 16 + qi; VT[t] = (const bf16_t*)(ws + WS_VT16) + hb + r[t] * 128; }
#pragma unroll 1
        for (int st = 0; st < 2; ++st) {
            const int k0 = st * 64;
#pragma unroll
            for (int t = 0; t < 2; ++t) {
                bf16x8 kf[2][2][2], vf[2][4];
#pragma unroll
                for (int hs = 0; hs < 2; ++hs) {
                    if (k0 + 32 * hs + 31 < blk * 16 - 64 || k0 + 32 * hs > blk * 16 + 79) continue;
#pragma unroll
                    for (int T = 0; T < 2; ++T) { const int kc = iclamp(k0 + 32 * hs + krow + 4 * T, 0, M - 1); const bf16_t* kp = Kb + (size_t)(r[t] + dil * kc) * ZW;
                        kf[hs][T][0] = *(const bf16x8*)kp; kf[hs][T][1] = *(const bf16x8*)(kp + 32); }
                    const int g = iclamp(k0 + 32 * hs + 8 * quad, 0, M - 8);
#pragma unroll
                    for (int dt = 0; dt < 4; ++dt) vf[hs][dt] = *(const bf16x8*)(VT[t] + (size_t)(dt * 16 + qi) * SEQ + g);
                }
#pragma unroll
                for (int hs = 0; hs < 2; ++hs) { if (k0 + 32 * hs + 31 < blk * 16 - 64 || k0 + 32 * hs > blk * 16 + 79) continue; attn_step(kf[hs], vf[hs], qf[t], o[t], mrun[t], lrun[t], k0 + 32 * hs, M, mq[t], quad); }
                __builtin_amdgcn_sched_barrier(0);
            }
        }
    }
    __syncthreads();
#pragma unroll 1
    for (int st = 0; st < 12; ++st) {
        const int kl = st * 32, k0 = s0 - 64 + kl;
        if (k0 + 31 < 0 || k0 >= SEQ) continue;
        bf16x8 kf[2][2], vf[4];
#pragma unroll
        for (int T = 0; T < 2; ++T)
#pragma unroll
            for (int ks = 0; ks < 2; ++ks) kf[T][ks] = *(const LAS bf16x8*)(Ks + (kl + krow + 4 * T) * 72 + ks * 32 + quad * 8);
#pragma unroll
        for (int dt = 0; dt < 4; ++dt) { const int colr = kl + 8 * quad + 8 * (2 * dt + (qi >> 3)); vf[dt] = *(const LAS bf16x8*)(Vs + (dt * 16 + qi) * 392 + (colr >= 384 ? colr - 384 : colr)); }
#pragma unroll
        for (int t = 0; t < 2; ++t) attn_step(kf, vf, qf[t], o[t], mrun[t], lrun[t], k0, SEQ, posq[t], quad);
    }
    {
        LAS bf16_t* K4s = (LAS bf16_t*)(lds + AT_KS); LAS bf16_t* V4s = (LAS bf16_t*)(lds + AT_VS);
        const int m0 = blk * 64 - 64;
#pragma unroll
        for (int p = 0; p < 2; ++p) {
            __syncthreads();
            int tl = tid; asm volatile("" : "+v"(tl));
#pragma unroll
            for (int i = 0; i < 6; ++i) { const int c = tl + 512 * i; const int cl = c >= 1536 ? 1 : 0; const int rem = c - cl * 1536;
                const int row = rem >> 3, ch = rem & 7; const int m = m0 + row;
                u32x4 kv = {0u, 0u, 0u, 0u}, vv = kv;
                if (m >= 0 && m < 512) { const bf16_t* zp = ZB + ((size_t)b * SEQ + 4 * m + 2 * p + cl) * ZW + h * 64 + ch * 8; kv = *(const u32x4*)(zp + 512); vv = *(const u32x4*)(zp + 1024); }
                *(LAS u32x4*)(K4s + (cl * 192 + row) * 72 + ch * 8) = kv;
                const int colw = row + 8 * ch; LAS bf16_t* vd = V4s + (cl * 64 + ch * 8) * 200 + (colw >= 192 ? colw - 192 : colw);
                vd[0 * 200] = (bf16_t)(vv.x & 0xffff); vd[1 * 200] = (bf16_t)(vv.x >> 16); vd[2 * 200] = (bf16_t)(vv.y & 0xffff); vd[3 * 200] = (bf16_t)(vv.y >> 16);
                vd[4 * 200] = (bf16_t)(vv.z & 0xffff); vd[5 * 200] = (bf16_t)(vv.z >> 16); vd[6 * 200] = (bf16_t)(vv.w & 0xffff); vd[7 * 200] = (bf16_t)(vv.w >> 16); }
            __syncthreads();
            const int cl = (jj2[p] & 3) - 2 * p; const int mq = blk * 64 + (jj2[p] >> 2) + 4 * qi;
#pragma unroll 1
            for (int st = 0; st < 6; ++st) {
                const int kl = st * 32;
                if (m0 + kl + 31 < 0 || m0 + kl >= 512) continue;
                bf16x8 kf[2][2], vf[4];
#pragma unroll
                for (int T = 0; T < 2; ++T)
#pragma unroll
                    for (int ks = 0; ks < 2; ++ks) kf[T][ks] = *(const LAS bf16x8*)(K4s + (cl * 192 + kl + krow + 4 * T) * 72 + ks * 32 + quad * 8);
#pragma unroll
                for (int dt = 0; dt < 4; ++dt) { const int colr = kl + 8 * quad + 8 * (2 * dt + (qi >> 3)); vf[dt] = *(const LAS bf16x8*)(V4s + (cl * 64 + dt * 16 + qi) * 200 + (colr >= 192 ? colr - 192 : colr)); }
                attn_step(kf, vf, qf[p], o[p], mrun[p], lrun[p], m0 + kl, 512, mq, quad);
            }
        }
    }
#pragma unroll
    for (int t = 0; t < 2; ++t) {
        float l = lrun[t]; l += __shfl_xor(l, 16); l += __shfl_xor(l, 32);
        const float inv = 1.0f / l;
#pragma unroll
        for (int dt = 0; dt < 4; ++dt) { u32x2 w; w.x = pk2(o[t][dt][0] * inv, o[t][dt][1] * inv); w.y = pk2(o[t][dt][2] * inv, o[t][dt][3] * inv);
            *(u32x2*)(MIX + tokq[t] * DM + h * 64 + dt * 16 + quad * 4) = w; }
    }
}

__device__ __forceinline__ void mlstm_post_row(const Params& P, int tok, int lane) {
    unsigned char* ws = P.ws;
    const bf16_t* HF = (const bf16_t*)P.out; const bf16_t* HBk = (const bf16_t*)P.out + (size_t)MTOK * 512; const bf16_t* ZB = (const bf16_t*)(ws + WS_ZB); bf16_t* MIX = (bf16_t*)(ws + WS_MIX);
    const u32x4 a = __builtin_nontemporal_load((const u32x4*)(HF + (size_t)tok * 512 + lane * 8)), c = __builtin_nontemporal_load((const u32x4*)(HBk + (size_t)tok * 512 + lane * 8));
    float v[8];
#pragma unroll
    for (int q = 0; q < 4; ++q) { v[2 * q] = bflo(a[q]) + bflo(c[q]); v[2 * q + 1] = bfhi(a[q]) + bfhi(c[q]); }
    float s = 0.f;
#pragma unroll
    for (int i = 0; i < 8; ++i) s += v[i];
#pragma unroll
    for (int o = 1; o < 16; o <<= 1) s += __shfl_xor(s, o);
    const float mu = s * (1.0f / 128.0f); float q2 = 0.f;
#pragma unroll
    for (int i = 0; i < 8; ++i) { v[i] -= mu; q2 += v[i] * v[i]; }
#pragma unroll
    for (int o = 1; o < 16; o <<= 1) q2 += __shfl_xor(q2, o);
    const float rs = rsqrtf(q2 * (1.0f / 128.0f) + EPSF);
    const u32x4 og = __builtin_nontemporal_load((const u32x4*)(ZB + (size_t)tok * ZW + 2560 + lane * 8));
    const f32x4 g0 = *(const f32x4*)(P.gn_g + lane * 8), g1 = *(const f32x4*)(P.gn_g + lane * 8 + 4);
    float y[8];
#pragma unroll
    for (int q = 0; q < 4; ++q) { const float o0 = bflo(og[q]), o1 = bfhi(og[q]); const float gg0 = q < 2 ? g0[2 * q] : g1[2 * q - 4], gg1 = q < 2 ? g0[2 * q + 1] : g1[2 * q - 3];
        y[2 * q] = v[2 * q] * rs * gg0 * sigmoidf_(o0); y[2 * q + 1] = v[2 * q + 1] * rs * gg1 * sigmoidf_(o1); }
    u32x4 w; w.x = pk2(y[0], y[1]); w.y = pk2(y[2], y[3]); w.z = pk2(y[4], y[5]); w.w = pk2(y[6], y[7]);
    *(u32x4*)(MIX + (size_t)tok * DM + 512 + lane * 8) = w;
}


#define XB_TMO      128
#define XB_XCNT(j)  (256  + 64 * (j))
#define XB_XSUB(j)  (1280 + 64 * (j))
#define XB_XGEN(j)  (2304 + 64 * (j))
#define XB_TOP      3328
#define XB_TOPGEN   3392
#define XCD_BAR_WORDS 3456
#define XB_SPIN_CAP (1u << 20)
__device__ __forceinline__ unsigned xb_ld(unsigned* p)              { return __hip_atomic_load(p, __ATOMIC_RELAXED, __HIP_MEMORY_SCOPE_AGENT); }
__device__ __forceinline__ unsigned xb_add(unsigned* p, unsigned v) { return __hip_atomic_fetch_add(p, v, __ATOMIC_RELAXED, __HIP_MEMORY_SCOPE_AGENT); }
__device__ __forceinline__ unsigned xb_xcc_id() { return (unsigned)__builtin_amdgcn_s_getreg((3 << 11) | 20) & 0xFu; }
#define XB_SPIN(cond, bar) do { unsigned _sp = 0; while (cond) { __builtin_amdgcn_s_sleep(1); \
    if ((++_sp & 255u) == 0u) { if (xb_ld(&(bar)[XB_TMO])) break; if (_sp > XB_SPIN_CAP) { atomicAdd(&(bar)[XB_TMO], 1u); break; } } } } while (0)
struct XcdBarrier { unsigned* bar; unsigned x; volatile LAS unsigned* st; };
__device__ __forceinline__ XcdBarrier xcd_barrier_post(unsigned* bar, volatile LAS unsigned* st) {
    XcdBarrier b; b.bar = bar; b.x = xb_xcc_id(); b.st = st;
    if (threadIdx.x == 0) (void)xb_add(&bar[XB_XCNT(b.x)], 1u);
    return b;
}
__device__ __forceinline__ void xcd_barrier_complete(unsigned* bar, unsigned x, unsigned& nloc, unsigned& nx) {
    const unsigned G = gridDim.x * gridDim.y * gridDim.z;
    unsigned sum, cnt, mine, sp = 0u;
    for (;;) {
        sum = 0u; cnt = 0u; mine = 0u;
#pragma unroll
        for (unsigned j = 0; j < 16; ++j) { const unsigned c = xb_ld(&bar[XB_XCNT(j)]); sum += c; cnt += (c > 0u) ? 1u : 0u; mine = (j == x) ? c : mine; }
        if (sum == G) break;
        __builtin_amdgcn_s_sleep(1);
        if ((++sp & 255u) == 0u) { if (xb_ld(&bar[XB_TMO])) break; if (sp > XB_SPIN_CAP) { atomicAdd(&bar[XB_TMO], 1u); break; } }
    }
    nloc = mine > 0u ? mine : 1u; nx = cnt > 0u ? cnt : 1u;
}
__device__ __forceinline__ void xcd_barrier(const XcdBarrier& b) {
    asm volatile("s_waitcnt vmcnt(0)" ::: "memory");
    __syncthreads();
    if (threadIdx.x == 0) {
        unsigned* bar = b.bar;
        __builtin_amdgcn_s_waitcnt(0);
        unsigned nloc = b.st[0], nx = b.st[1];
        if (nloc == 0u) { xcd_barrier_complete(bar, b.x, nloc, nx); b.st[0] = nloc; b.st[1] = nx; }
        const unsigned old = xb_add(&bar[XB_XSUB(b.x)], 1u);
        const unsigned gen = old / nloc;
        if (old + 1u == (gen + 1u) * nloc) {
            __builtin_amdgcn_fence(__ATOMIC_RELEASE, "agent");
            asm volatile("s_waitcnt vmcnt(0)" ::: "memory");
            const unsigned og = xb_add(&bar[XB_TOP], 1u);
            const unsigned tg = og / nx;
            if (og + 1u == (tg + 1u) * nx) xb_add(&bar[XB_TOPGEN], 1u);
            else XB_SPIN(xb_ld(&bar[XB_TOPGEN]) == tg, bar);
            __builtin_amdgcn_fence(__ATOMIC_ACQUIRE, "agent");
            xb_add(&bar[XB_XGEN(b.x)], 1u);
            asm volatile("s_waitcnt vmcnt(0)" ::: "memory");
        } else {
            XB_SPIN(xb_ld(&bar[XB_XGEN(b.x)]) == gen, bar);
            __builtin_amdgcn_fence(__ATOMIC_ACQUIRE, "agent");
            asm volatile("s_waitcnt vmcnt(0)" ::: "memory");
        }
    }
    __syncthreads();
}
#define GRID_SYNC() xcd_barrier(xbar)
__global__ void __launch_bounds__(512) fwd_megakernel(Params P) {
    extern __shared__ __attribute__((aligned(16))) unsigned char lds_raw[];
    LAS unsigned char* lds = (LAS unsigned char*)lds_raw;
    cg::grid_group grid = cg::this_grid();
    const int G = gridDim.x, bid = blockIdx.x;
    unsigned char* ws = P.ws;
    if (G == 0x7fffffff) grid.sync();
    { volatile LAS unsigned* stw = (volatile LAS unsigned*)(lds + LDS_ST_OFF); if (threadIdx.x < 4) stw[threadIdx.x] = 0u; }
    __syncthreads();
    const XcdBarrier xbar = xcd_barrier_post((unsigned*)(ws + WS_BAR), (volatile LAS unsigned*)(lds + LDS_ST_OFF));

    for (int rep = 0; rep < REP_MISC; ++rep) phase_prologue(P, lds, G);
    GRID_SYNC();
    {
        pg8::Gemm g{(const bf16_t*)(ws + WS_XB), (const bf16_t*)(ws + WS_WIN), MTOK, NZPAD, DM}; pg8::StaticOrder S; S.init(MTOK, NZPAD, G, bid);
        pg8::EpiZ E{(bf16_t*)(ws + WS_ZB), (float*)(ws + WS_GATES), (const float*)(ws + WS_R0), (const float*)(ws + WS_CS), (bf16_t*)(ws + WS_VT16)};
        for (int rep = 0; rep < REP_G; ++rep) pg8::gemm_phase<pg8::EpiZ, true>(lds, g, S, E);
    }
    GRID_SYNC();
#ifdef PROBE_STOP
    if (PROBE_STOP == 1) {
        int tid = threadIdx.x; asm volatile("" : "+v"(tid));
        for (size_t i = (size_t)bid * 512 + tid; i < (size_t)MTOK * DM; i += (size_t)G * 512) {
            const size_t m = i >> 10, c = i & 1023; float v;
            if (PROBE_STOP == 1) { const bf16_t* ZBp = (const bf16_t*)(ws + WS_ZB); v = bf1(ZBp[m * ZW + c]) + bf1(ZBp[m * ZW + c + 1024]) + bf1(ZBp[m * ZW + c + 2048]) + ((const float*)(ws + WS_GATES))[m * 16 + (c & 15)]; }
            else if (PROBE_STOP == 2) { v =
#ifndef PROBE_NOSCAN
 bf1(((const bf16_t*)(ws + WS_HF))[m * 512 + (c & 511)]) + bf1(((const bf16_t*)(ws + WS_HB))[m * 512 + (c & 511)]) +
#endif
 bf1(((const bf16_t*)(ws + WS_VT1))[i]) + bf1(((const bf16_t*)(ws + WS_VT4))[i]) + bf1(((const bf16_t*)(ws + WS_VT16))[i]); }
            else { v = bf1(((const bf16_t*)(ws + WS_MIX))[i]); }
            if (!(fabsf(v) < 1e30f)) v = 12345.f;
            P.out[i] = v; }
        return;
    }
#endif
    {
        int tid = threadIdx.x; asm volatile("" : "+v"(tid));
        const int nscan = G >= 256 ? 128 : (G > 1 ? G / 2 : 1);
        if (bid < nscan) for (int it = bid; it < 128; it += nscan) scan_item(P, lds, it);
        unsigned* queue = (unsigned*)(ws + WS_BAR) + 3520;
        volatile LAS unsigned* qw = (volatile LAS unsigned*)(lds + LDS_ST_OFF + 16);
        for (;;) {
            __syncthreads();
            if (tid == 0) qw[0] = __hip_atomic_fetch_add(queue, 1u, __ATOMIC_RELAXED, __HIP_MEMORY_SCOPE_AGENT);
            __syncthreads();
            const int u = (int)qw[0];
            if (u >= NB * 8 * 8) break;
            attn_unit(P, lds, u >> 6, (u >> 3) & 7, u & 7, tid);
        }
    }
    GRID_SYNC();
    {
        int tid = threadIdx.x; asm volatile("" : "+v"(tid));
        const int lane = tid & 63, wave = tid >> 6;
        for (int tok = bid * 8 + wave; tok < MTOK; tok += G * 8) mlstm_post_row(P, tok, lane);
    }
    GRID_SYNC();
    {
        pg8::Gemm g{(const bf16_t*)(ws + WS_MIX), (const bf16_t*)(ws + WS_WOUT), MTOK, DM, DM}; pg8::StaticOrder S; S.init(MTOK, DM, G, bid);
        pg8::EpiRes<true> E{nullptr, (bf16_t*)(ws + WS_XB), (float*)(ws + WS_SS1)};
        pg8::gemm_phase<pg8::EpiRes<true>, true>(lds, g, S, E);
    }
    GRID_SYNC();
    {
        pg8::Gemm g{(const bf16_t*)(ws + WS_XB), (const bf16_t*)(ws + WS_WG), MTOK, NGU, DM}; pg8::StaticOrder S; S.init(MTOK, NGU, G, bid);
        pg8::EpiGU E{(bf16_t*)(ws + WS_ACT), (const float*)(ws + WS_SS1), P.fconv_w, P.fconv_b, (float*)(ws + WS_HALO), (LAS float*)(lds + 131072)};
        pg8::gemm_phase<pg8::EpiGU, true>(lds, g, S, E);
    }
    GRID_SYNC();
    {
        int tid = threadIdx.x; asm volatile("" : "+v"(tid));
        const float* HALO = (const float*)(ws + WS_HALO); bf16_t* ACT = (bf16_t*)(ws + WS_ACT);
        for (int idx = bid * 512 + tid; idx < (MTOK / 256) * 2 * FF; idx += G * 512) {
            const int col = idx % FF; const int pe_ = idx / FF; const int e = pe_ & 1, pm = pe_ >> 1;
            const float* H = HALO + (size_t)((pm * 2 + e) * 3) * FF;
            float a = H[FF + col]; const float uu = H[2 * FF + col];
            if (e == 0) { if ((pm & 7) != 0) a += HALO[(size_t)(((pm - 1) * 2 + 1) * 3) * FF + col] * P.fconv_w[col]; }
            else        { if ((pm & 7) != 7) a += HALO[(size_t)(((pm + 1) * 2 + 0) * 3) * FF + col] * P.fconv_w[2 * FF + col]; }
            const int row = pm * 256 + (e ? 255 : 0);
            ACT[(size_t)row * FF + col] = (bf16_t)f2bf(gelu1(a) * uu);
        }
    }
    GRID_SYNC();
    {
        pg8::Gemm g{(const bf16_t*)(ws + WS_ACT), (const bf16_t*)(ws + WS_WD), MTOK, DM, FF}; pg8::StaticOrder S; S.init(MTOK, DM, G, bid);
        pg8::EpiRes<true> E{nullptr, (bf16_t*)(ws + WS_XB), (float*)(ws + WS_SS2)};
        pg8::gemm_phase<pg8::EpiRes<true>, true>(lds, g, S, E);
    }
    GRID_SYNC();
    {
        pg8::Gemm g{(const bf16_t*)(ws + WS_XB), (const bf16_t*)(ws + WS_WPG), MTOK, DM, DM}; pg8::StaticOrder S; S.init(MTOK, DM, G, bid);
        {
            int kpp = 256; asm volatile("" : "+s"(kpp));
            pg8::Gemm g2{(const bf16_t*)(ws + WS_PB), (const bf16_t*)(ws + WS_WPP), MTOK, DM, kpp}; pg8::StaticOrder S2; S2.init(MTOK, DM, G, bid);
            pg8::EpiStore E2{(bf16_t*)P.out};
            pg8::gemm_phase<pg8::EpiStore, true>(lds, g2, S2, E2);
            asm volatile("s_waitcnt vmcnt(0)" ::: "memory"); __syncthreads();
        }
        pg8::EpiSigPle E{(bf16_t*)(ws + WS_XB), (const bf16_t*)P.out, (const float*)(ws + WS_SS2), P.b_pg, (float*)(ws + WS_SS3)};
        pg8::gemm_phase<pg8::EpiSigPle, true>(lds, g, S, E);
    }
    GRID_SYNC();
    for (int rep = 0; rep < REP_SYNC; ++rep) GRID_SYNC();
    {
        int tid = threadIdx.x; asm volatile("" : "+v"(tid));
        const int lane = tid & 63, wave = tid >> 6;
        const float* ss3 = (const float*)(ws + WS_SS3);
        f32x4 gv[4];
#pragma unroll
        for (int j = 0; j < 4; ++j) gv[j] = *((const f32x4*)P.ln_f_g + lane + 64 * j);
        const int NW = G * 8;
        for (int m0 = bid * 8 + wave; m0 < MTOK; m0 += 2 * NW) {
            const int m1 = (m0 + NW < MTOK) ? m0 + NW : m0;
            u32x2 xv[2][4]; float sv[2];
#pragma unroll
            for (int q = 0; q < 2; ++q) { const int m = q ? m1 : m0; sv[q] = ss3[m]; const u32x2* xr = (const u32x2*)((const bf16_t*)(ws + WS_XB) + (size_t)m * DM) + lane;
#pragma unroll
                for (int j = 0; j < 4; ++j) xv[q][j] = __builtin_nontemporal_load(xr + 64 * j); }
#pragma unroll
            for (int q = 0; q < 2; ++q) { const int m = q ? m1 : m0;
                if (q == 1 && m1 == m0) break;
                const float r = rsqrtf(sv[q] * (1.0f / DM) + EPSF);
                f32x4* orow = (f32x4*)(P.out + (size_t)m * DM) + lane;
#pragma unroll
                for (int j = 0; j < 4; ++j) { const f32x4 v = {bflo(xv[q][j].x), bfhi(xv[q][j].x), bflo(xv[q][j].y), bfhi(xv[q][j].y)}; __builtin_nontemporal_store(v * r * gv[j], orow + 64 * j); } }
        }
    }
}

extern "C" void kernel_launch(void* const* d_in, const int* in_sizes, int n_in, void* d_out, int out_size, void* d_ws, size_t ws_size, hipStream_t stream) {
    static int grid_blocks = 0;
    if (grid_blocks == 0) {
        if (n_in != 24 || ws_size < WS_NEED) { fprintf(stderr, "kernel_launch: unexpected n_in %d / ws %zu\n", n_in, ws_size); grid_blocks = -1; return; }
        int dev = 0, cus = 0, per_cu = 0;
        hipGetDevice(&dev);
        hipDeviceGetAttribute(&cus, hipDeviceAttributeMultiprocessorCount, dev);
        if (hipFuncSetAttribute((const void*)fwd_megakernel, hipFuncAttributeMaxDynamicSharedMemorySize, LDS_BYTES) != hipSuccess) { fprintf(stderr, "hipFuncSetAttribute failed\n"); grid_blocks = -1; return; }
        if (hipOccupancyMaxActiveBlocksPerMultiprocessor(&per_cu, (const void*)fwd_megakernel, 512, LDS_BYTES) != hipSuccess || per_cu < 1) { fprintf(stderr, "occupancy query failed (%d)\n", per_cu); per_cu = 1; }
        (void)hipGetLastError();
        grid_blocks = cus * 1;
        if (grid_blocks <= 0) grid_blocks = 256;
    }
    if (grid_blocks < 0) return;
    Params P{};
    P.x = (const float*)d_in[0]; P.p = (const float*)d_in[1]; P.pos = (const int*)d_in[2];
    P.ln_mix_g = (const float*)d_in[3]; P.w_in = (const float*)d_in[4]; P.mconv_w = (const float*)d_in[5]; P.mconv_b = (const float*)d_in[6];
    P.w_mq = (const float*)d_in[7]; P.w_mk = (const float*)d_in[8]; P.b_ig = (const float*)d_in[9]; P.b_fg = (const float*)d_in[10]; P.gn_g = (const float*)d_in[11];
    P.w_out = (const float*)d_in[12]; P.ln_ffn_g = (const float*)d_in[13]; P.w_fg = (const float*)d_in[14]; P.fconv_w = (const float*)d_in[15]; P.fconv_b = (const float*)d_in[16];
    P.w_fu = (const float*)d_in[17]; P.w_fd = (const float*)d_in[18]; P.ln_ple_g = (const float*)d_in[19]; P.w_pg = (const float*)d_in[20]; P.b_pg = (const float*)d_in[21];
    P.w_pp = (const float*)d_in[22]; P.ln_f_g = (const float*)d_in[23];
    P.out = (float*)d_out; P.ws = (unsigned char*)d_ws;
    for (int j = 0; j < 8; ++j) P.invrev[j] = std::pow(500000.0, -(double)j / 8.0) / 6.283185307179586476925;
    if (hipMemsetAsync((unsigned char*)d_ws + WS_BAR, 0, 16384, stream) != hipSuccess) { fprintf(stderr, "memset failed\n"); return; }
    void* args[] = {&P};
    hipError_t e = hipLaunchCooperativeKernel((const void*)fwd_megakernel, dim3(grid_blocks), dim3(512), args, LDS_BYTES, stream);
    if (e != hipSuccess) fprintf(stderr, "cooperative launch failed: %s (grid %d)\n", hipGetErrorString(e), grid_blocks);
}
```
